# Optimizing an MI355X kernel written in HIP

```python
import math
import jax, jax.numpy as jnp
from jax import lax
import numpy as np

D_MODEL = 1024
BATCH = 4
SEQ = 8192
DEPTH = 4

GRID_W = 64
CTX_LEN = 256
HEAD_DIM = 64
NA_WIDTH = D_MODEL // 2
NA_HEADS = NA_WIDTH // HEAD_DIM
NA_WIN_ROWS = 8
NA_WIN_COLS = 16
LRU_WIDTH = D_MODEL - NA_WIDTH
LRU_BLOCKS = 8
LRU_BLOCK = LRU_WIDTH // LRU_BLOCKS
CONV_W = 4
CONV_LEFT = (CONV_W - 1) // 2
LRU_C = 8.0
MIX_WIDTH = NA_WIDTH + LRU_WIDTH
IN_COLS = 3 * NA_WIDTH + 2 * LRU_WIDTH
SPLITS = (NA_WIDTH, 2 * NA_WIDTH, 3 * NA_WIDTH, 3 * NA_WIDTH + LRU_WIDTH)
N_EXPERTS = 16
N_GROUPS = 4
EXPERTS_PER_GROUP = N_EXPERTS // N_GROUPS
TOP_K = 2
EXPERT_FF = D_MODEL // 2
N_MOD = 6
ATTN_SCALE = HEAD_DIM ** -0.5
EPS = 1e-6
NEG_INF = -1e30

kernel_name = "hybrid_natten_rglru_groupmoe_dit"


def _rms(x, g):
    xf = x.astype(jnp.float32)
    y = xf * lax.rsqrt(jnp.mean(xf * xf, axis=-1, keepdims=True) + EPS)
    return (y * g.astype(jnp.float32)).astype(x.dtype)


def _ada(cvec, w, b):
    m = jax.nn.silu(cvec) @ w + b
    return jnp.split(m[..., None, :], N_MOD, axis=-1)


def _qk_heads(t, g):
    B, L, _ = t.shape
    t = _rms(t.reshape(B, L, NA_HEADS, HEAD_DIM), g)
    return t.transpose(0, 2, 1, 3)


def _heads(t):
    B, L, _ = t.shape
    return t.reshape(B, L, NA_HEADS, HEAD_DIM).transpose(0, 2, 1, 3)


def _merge(t):
    B, H, L, hd = t.shape
    return t.transpose(0, 2, 1, 3).reshape(B, L, H * hd)


def _na_mixer(qx, kx, vx, qc, kc, vc, bias_table):
    B, H, N, hd = qx.shape
    rows = N // GRID_W
    kh = min(NA_WIN_ROWS, rows)
    kw = NA_WIN_COLS
    r = jnp.arange(rows)
    row0 = jnp.clip(r - kh // 2, 0, rows - kh)
    key_rows = row0[:, None] + jnp.arange(kh)[None, :]
    col = jnp.arange(GRID_W)
    col0 = jnp.clip(col - kw // 2, 0, GRID_W - kw)
    in_win = (col[None, :] >= col0[:, None]) & (col[None, :] < col0[:, None] + kw)
    r_idx = key_rows - r[:, None] + (NA_WIN_ROWS - 1)
    c_idx = jnp.clip(col[None, :] - col[:, None], -(kw - 1), kw - 1) + (NA_WIN_COLS - 1)
    bias = bias_table[:, r_idx[:, None, :, None], c_idx[None, :, None, :]]
    bias = jnp.where(in_win[None, None, :, None, :], bias.astype(jnp.float32), NEG_INF)
    bias = bias.reshape(H, rows, GRID_W, kh * GRID_W)

    qg = qx.reshape(B, H, rows, GRID_W, hd)
    kg = kx.reshape(B, H, rows, GRID_W, hd)[:, :, key_rows].reshape(B, H, rows, kh * GRID_W, hd)
    vg = vx.reshape(B, H, rows, GRID_W, hd)[:, :, key_rows].reshape(B, H, rows, kh * GRID_W, hd)
    n_loc = kh * GRID_W
    s_loc = jnp.einsum('bhrqd,bhrkd->bhrqk', qg, kg).astype(jnp.float32) + bias[None]
    s_ctx = jnp.einsum('bhrqd,bhcd->bhrqc', qg, kc).astype(jnp.float32)
    p = jax.nn.softmax(jnp.concatenate([s_loc, s_ctx], axis=-1), axis=-1).astype(vx.dtype)
    o = (jnp.einsum('bhrqk,bhrkd->bhrqd', p[..., :n_loc], vg)
         + jnp.einsum('bhrqc,bhcd->bhrqd', p[..., n_loc:], vc))
    yx = _merge(o.reshape(B, H, N, hd))
    yc = None
    if qc is not None:
        pc = jax.nn.softmax(jnp.einsum('bhqd,bhkd->bhqk', qc, kc).astype(jnp.float32), axis=-1)
        yc = _merge(jnp.einsum('bhqk,bhkd->bhqd', pc.astype(vc.dtype), vc))
    return yx, yc


def _dwconv(u, w, b):
    L = u.shape[1]
    up = jnp.pad(u, ((0, 0), (CONV_LEFT, CONV_W - 1 - CONV_LEFT), (0, 0)))
    out = up[:, 0:L] * w[0]
    for k in range(1, CONV_W):
        out = out + up[:, k:k + L] * w[k]
    return out + b


def _block_diag(u, w, b):
    B, L, _ = u.shape
    ub = u.reshape(B, L, LRU_BLOCKS, LRU_BLOCK)
    return jnp.einsum('blnd,nde->blne', ub, w.astype(jnp.float32)).reshape(B, L, LRU_WIDTH) + b.astype(jnp.float32)


def _rglru_coeffs(u, w_r, b_r, w_i, b_i, lam):
    uf = u.astype(jnp.float32)
    r_t = jax.nn.sigmoid(_block_diag(uf, w_r, b_r))
    i_t = jax.nn.sigmoid(_block_diag(uf, w_i, b_i))
    log_a = -LRU_C * r_t * jax.nn.softplus(-lam.astype(jnp.float32))
    a = jnp.exp(log_a)
    b = jnp.sqrt(-jnp.expm1(2.0 * log_a)) * (i_t * uf)
    return a, b


def _comb(left, right):
    a_l, b_l = left
    a_r, b_r = right
    return a_l * a_r, a_r * b_l + b_r


def _linear_scan(a, b, h0, reverse):
    if reverse:
        a, b = jnp.flip(a, 1), jnp.flip(b, 1)
    A, H = lax.associative_scan(_comb, (a, b), axis=1)
    if h0 is not None:
        H = H + A * h0[:, None, :]
    final = H[:, -1]
    if reverse:
        H = jnp.flip(H, 1)
    return H, final


def _rglru_mixer(ux, gx, uc, gc, conv_w, conv_b, w_r, b_r, w_i, b_i, lam):
    ux = _dwconv(ux, conv_w, conv_b)
    uc = _dwconv(uc, conv_w, conv_b)
    hx_sum = None
    hc_sum = None
    for d, rev in enumerate((False, True)):
        ac, bc = _rglru_coeffs(uc, w_r[d], b_r[d], w_i[d], b_i[d], lam[d])
        Hc, hc_final = _linear_scan(ac, bc, None, rev)
        ax, bx = _rglru_coeffs(ux, w_r[d], b_r[d], w_i[d], b_i[d], lam[d])
        Hx, _ = _linear_scan(ax, bx, hc_final, rev)
        hx_sum = Hx if hx_sum is None else hx_sum + Hx
        hc_sum = Hc if hc_sum is None else hc_sum + Hc
    yx = (jax.nn.gelu(gx.astype(jnp.float32)) * hx_sum).astype(gx.dtype)
    yc = None
    if gc is not None:
        yc = (jax.nn.gelu(gc.astype(jnp.float32)) * hc_sum).astype(gc.dtype)
    return yx, yc


def _moe(h, router_w, router_b, w1, w3, w2):
    B, L, _ = h.shape
    aff = jax.nn.sigmoid(jnp.einsum('bld,de->ble', h.astype(jnp.float32), router_w.astype(jnp.float32)))
    sel = aff + router_b.astype(jnp.float32)
    grp_score = lax.top_k(sel.reshape(B, L, N_GROUPS, EXPERTS_PER_GROUP), TOP_K)[0].sum(-1)
    best = jnp.argmax(grp_score, axis=-1)
    expert_group = jnp.arange(N_EXPERTS) // EXPERTS_PER_GROUP
    sel = jnp.where(expert_group == best[..., None], sel, NEG_INF)
    _, idx = lax.top_k(sel, TOP_K)
    wts = jnp.take_along_axis(aff, idx, axis=-1)
    wts = wts / jnp.sum(wts, axis=-1, keepdims=True)
    gates = jnp.einsum('blk,blke->ble', wts, jax.nn.one_hot(idx, N_EXPERTS, dtype=jnp.float32)).astype(h.dtype)
    out = jnp.zeros_like(h)
    for e in range(N_EXPERTS):
        y = (jax.nn.silu(h @ w1[e]) * (h @ w3[e])) @ w2[e]
        out = out + gates[..., e:e + 1] * y
    return out


def setup_inputs(seed: int = 0) -> dict:
    key = jax.random.key(seed)
    ks = jax.random.split(key, 26)
    f32 = jnp.float32

    def nrm(k, shape, fan_in, scale=1.0):
        return jax.random.normal(k, shape, f32) * (scale * fan_in ** -0.5)

    x = jax.random.normal(ks[0], (BATCH, SEQ, D_MODEL), f32)
    c = jax.random.normal(ks[1], (BATCH, D_MODEL), f32)
    ctx = jax.random.normal(ks[2], (BATCH, CTX_LEN, D_MODEL), f32)
    c_ctx = jax.random.normal(ks[3], (D_MODEL,), f32)
    w_mod = nrm(ks[4], (DEPTH, D_MODEL, N_MOD * D_MODEL), D_MODEL, 0.5)
    b_mod = 0.02 * jax.random.normal(ks[5], (DEPTH, N_MOD * D_MODEL), f32)
    norm_mix = 1.0 + 0.05 * jax.random.normal(ks[6], (DEPTH, D_MODEL), f32)
    norm_ffn = 1.0 + 0.05 * jax.random.normal(ks[7], (DEPTH, D_MODEL), f32)
    w_in = nrm(ks[8], (DEPTH, D_MODEL, IN_COLS), D_MODEL)
    w_out = nrm(ks[9], (DEPTH, MIX_WIDTH, D_MODEL), MIX_WIDTH)
    q_gain = 1.0 + 0.05 * jax.random.normal(ks[10], (DEPTH, HEAD_DIM), f32)
    k_gain = 1.0 + 0.05 * jax.random.normal(ks[11], (DEPTH, HEAD_DIM), f32)
    na_bias = 0.1 * jax.random.normal(ks[12], (DEPTH, NA_HEADS, 2 * NA_WIN_ROWS - 1, 2 * NA_WIN_COLS - 1), f32)
    conv_w = nrm(ks[13], (DEPTH, CONV_W, LRU_WIDTH), CONV_W)
    conv_b = 0.02 * jax.random.normal(ks[14], (DEPTH, LRU_WIDTH), f32)
    lru_w_r = nrm(ks[15], (DEPTH, 2, LRU_BLOCKS, LRU_BLOCK, LRU_BLOCK), LRU_BLOCK)
    lru_b_r = 0.02 * jax.random.normal(ks[16], (DEPTH, 2, LRU_WIDTH), f32)
    lru_w_i = nrm(ks[17], (DEPTH, 2, LRU_BLOCKS, LRU_BLOCK, LRU_BLOCK), LRU_BLOCK)
    lru_b_i = 0.02 * jax.random.normal(ks[18], (DEPTH, 2, LRU_WIDTH), f32)
    a_c = jax.random.uniform(ks[19], (DEPTH, 2, LRU_WIDTH), f32, 0.9, 0.999)
    a0 = a_c ** (1.0 / LRU_C)
    lru_lambda = jnp.log(a0) - jnp.log1p(-a0)
    router_w = nrm(ks[20], (D_MODEL, N_EXPERTS), D_MODEL)
    router_b = 0.01 * jax.random.normal(ks[21], (N_EXPERTS,), f32)
    exp_w1 = nrm(ks[22], (DEPTH, N_EXPERTS, D_MODEL, EXPERT_FF), D_MODEL)
    exp_w3 = nrm(ks[23], (DEPTH, N_EXPERTS, D_MODEL, EXPERT_FF), D_MODEL)
    exp_w2 = nrm(ks[24], (DEPTH, N_EXPERTS, EXPERT_FF, D_MODEL), EXPERT_FF)
    return {"x": x, "c": c, "ctx": ctx, "c_ctx": c_ctx, "w_mod": w_mod, "b_mod": b_mod,
            "norm_mix": norm_mix, "norm_ffn": norm_ffn, "w_in": w_in, "w_out": w_out,
            "q_gain": q_gain, "k_gain": k_gain, "na_bias": na_bias, "conv_w": conv_w, "conv_b": conv_b,
            "lru_w_r": lru_w_r, "lru_b_r": lru_b_r, "lru_w_i": lru_w_i, "lru_b_i": lru_b_i,
            "lru_lambda": lru_lambda, "router_w": router_w, "router_b": router_b,
            "exp_w1": exp_w1, "exp_w3": exp_w3, "exp_w2": exp_w2}


def reference(x, c, ctx, c_ctx, w_mod, b_mod, norm_mix, norm_ffn, w_in, w_out, q_gain, k_gain,
              na_bias, conv_w, conv_b, lru_w_r, lru_b_r, lru_w_i, lru_b_i, lru_lambda,
              router_w, router_b, exp_w1, exp_w3, exp_w2):
    xc = ctx
    n_ctx = ctx.shape[1]
    for l in range(DEPTH):
        last = l == DEPTH - 1
        sh_ax, sc_ax, g_ax, sh_fx, sc_fx, g_fx = _ada(c, w_mod[l], b_mod[l])
        sh_ac, sc_ac, g_ac, sh_fc, sc_fc, g_fc = _ada(c_ctx, w_mod[l], b_mod[l])

        hx = _rms(x, norm_mix[l]) * (1 + sc_ax) + sh_ax
        hc = _rms(xc, norm_mix[l]) * (1 + sc_ac) + sh_ac
        qx, kx, vx, ux, gx = jnp.split(hx @ w_in[l], SPLITS, axis=-1)
        if last:
            kc, vc, uc = jnp.split(hc @ w_in[l][:, NA_WIDTH:3 * NA_WIDTH + LRU_WIDTH],
                                   (NA_WIDTH, 2 * NA_WIDTH), axis=-1)
            qc_h = None
            gc = None
        else:
            qc, kc, vc, uc, gc = jnp.split(hc @ w_in[l], SPLITS, axis=-1)
            qc_h = _qk_heads(qc, q_gain[l]) * ATTN_SCALE
        ya_x, ya_c = _na_mixer(_qk_heads(qx, q_gain[l]) * ATTN_SCALE, _qk_heads(kx, k_gain[l]), _heads(vx),
                               qc_h, _qk_heads(kc, k_gain[l]), _heads(vc), na_bias[l])
        yb_x, yb_c = _rglru_mixer(ux, gx, uc, gc, conv_w[l], conv_b[l], lru_w_r[l], lru_b_r[l],
                                  lru_w_i[l], lru_b_i[l], lru_lambda[l])
        x = x + g_ax * (jnp.concatenate([ya_x, yb_x], axis=-1) @ w_out[l])

        hx = _rms(x, norm_ffn[l]) * (1 + sc_fx) + sh_fx
        if last:
            x = x + g_fx * _moe(hx, router_w, router_b, exp_w1[l], exp_w3[l], exp_w2[l])
        else:
            xc = xc + g_ac * (jnp.concatenate([ya_c, yb_c], axis=-1) @ w_out[l])
            hc = _rms(xc, norm_ffn[l]) * (1 + sc_fc) + sh_fc
            f = _moe(jnp.concatenate([hc, hx], axis=1), router_w, router_b, exp_w1[l], exp_w3[l], exp_w2[l])
            xc = xc + g_fc * f[:, :n_ctx]
            x = x + g_fx * f[:, n_ctx:]
    return x
```

```cpp
#include <hip/hip_runtime.h>
#include <cstdio>
#include <cstdint>

#ifndef PH_MASK
#define PH_MASK 0x3ff
#endif
#define PHM(i) ((PH_MASK >> (i)) & 1)
#ifndef EPI_ALIGN_RMW
#define EPI_ALIGN_RMW true
#endif
#ifndef PROBE_REP
#define PROBE_REP -1
#endif
#ifndef MK_MULTI
#define MK_MULTI 0
#endif

#define LAS __attribute__((address_space(3)))
#define DI __device__ __forceinline__
typedef unsigned short bf16_t;
typedef short bf16x8 __attribute__((ext_vector_type(8)));
typedef short s16x4 __attribute__((ext_vector_type(4)));
typedef short v4i16_t __attribute__((ext_vector_type(4)));
typedef float f32x2 __attribute__((ext_vector_type(2)));
typedef float f32x4 __attribute__((ext_vector_type(4)));
typedef float f32x16 __attribute__((ext_vector_type(16)));
typedef unsigned u32x2 __attribute__((ext_vector_type(2)));
typedef unsigned u32x4 __attribute__((ext_vector_type(4)));
typedef __bf16 bf16x2_t __attribute__((ext_vector_type(2)));

constexpr int D = 1024, DEPTH = 4, SEQ = 8192, NB = 4, CTX = 256;
constexpr int RL = NB * SEQ;
constexpr int RC = NB * CTX;
constexpr int R = RL + RC;
constexpr int NIN = 2560;
constexpr int NCLS = 24, CAP = R + 256;
constexpr int NCHUNK = R / 64;
constexpr float EPS = 1e-6f;
constexpr float LOG2E = 1.4426950408889634f;
constexpr float QSCALE = 0.125f * LOG2E;
constexpr float NEGBIG = -1e30f;

constexpr size_t MiB = 1u << 20;
constexpr size_t WS_CTL = 0, CTL_BYTES = 131072;
constexpr size_t WS_MOD = 1 * MiB;
constexpr size_t WS_SP8 = 2 * MiB;
constexpr size_t WS_GATEW = 3 * MiB;
constexpr size_t WS_WIN = 4 * MiB;
constexpr size_t WS_WOUT = 24 * MiB;
constexpr size_t WS_WUP = 32 * MiB;
constexpr size_t WS_WDN = 160 * MiB;
constexpr size_t WS_HB = 224 * MiB;
constexpr size_t WS_QKV = 290 * MiB;
constexpr size_t QKV_STRIDE = 33 * MiB;
constexpr size_t WS_XC = 455 * MiB;
constexpr size_t WS_AGG = 459 * MiB;
constexpr size_t WS_CARRY = 464 * MiB;
constexpr size_t WS_LIST = 467 * MiB;
constexpr size_t WS_WTL = 471 * MiB;
constexpr size_t WS_XB = 480 * MiB;
constexpr size_t WS_END = 546 * MiB;
static_assert((size_t)R * 512 * 2 <= QKV_STRIDE && (size_t)(R + NCLS * 256) * 2048 <= 5 * QKV_STRIDE, "ws map");
static_assert((size_t)NCLS * CAP * 4 <= 4 * MiB && (size_t)NCLS * CAP * 8 <= 7 * MiB, "ws map lists");
constexpr int CW_BAR = 1024;
constexpr int CW_CLS = 8192;
constexpr int CW_PAN = 12288;
constexpr int CW_ECTX = 14336;
constexpr int CW_DONE = 16384;
constexpr int NCTX_IN = 40, NCTX_OUT = 16;

constexpr int LDS_BYTES = 147456;
constexpr int LDS_MISC = 131072;
constexpr int MISC_BAR = LDS_MISC + 320;
constexpr int MISC_CLS = LDS_MISC + 1024;

DI unsigned pk2(float lo, float hi) { f32x2 v = {lo, hi}; bf16x2_t b = __builtin_convertvector(v, bf16x2_t); return __builtin_bit_cast(unsigned, b); }
DI float bflo(unsigned w) { return __uint_as_float(w << 16); }
DI float bfhi(unsigned w) { return __uint_as_float(w & 0xffff0000u); }
DI void unpack8(const u32x4 w, f32x4& a, f32x4& b) { a = (f32x4){bflo(w.x), bfhi(w.x), bflo(w.y), bfhi(w.y)}; b = (f32x4){bflo(w.z), bfhi(w.z), bflo(w.w), bfhi(w.w)}; }
DI u32x4 pack8(const f32x4 a, const f32x4 b) { u32x4 w; w.x = pk2(a.x, a.y); w.y = pk2(a.z, a.w); w.z = pk2(b.x, b.y); w.w = pk2(b.z, b.w); return w; }
template <int O> DI float shx(float v) {
    int i = __float_as_int(v);
    if constexpr (O == 1) i = __builtin_amdgcn_mov_dpp(i, 0xB1, 0xf, 0xf, true);
    else if constexpr (O == 2) i = __builtin_amdgcn_mov_dpp(i, 0x4E, 0xf, 0xf, true);
    else i = __builtin_amdgcn_ds_swizzle(i, 0x1f | (O << 10));
    return __int_as_float(i);
}
DI float xsum32(float v) { const unsigned u = __float_as_uint(v); const auto r = __builtin_amdgcn_permlane32_swap(u, u, false, false); return __uint_as_float(r[0]) + __uint_as_float(r[1]); }
DI float xmax32(float v) { const unsigned u = __float_as_uint(v); const auto r = __builtin_amdgcn_permlane32_swap(u, u, false, false); return fmaxf(__uint_as_float(r[0]), __uint_as_float(r[1])); }
DI float wave_sum(float v) { v += shx<1>(v); v += shx<2>(v); v += shx<4>(v); v += shx<8>(v); v += shx<16>(v); return xsum32(v); }
DI float fexp2(float x) { return __builtin_amdgcn_exp2f(x); }
DI float frcp(float x) { return __builtin_amdgcn_rcpf(x); }
DI float sigmoidf_(float x) { return frcp(1.0f + fexp2(-LOG2E * x)); }
DI float gelu_tanh(float x) { const float u = 0.7978845608028654f * (x + 0.044715f * x * x * x); return x * frcp(1.0f + fexp2(-2.0f * LOG2E * u)); }
#define LDS_WAIT() asm volatile("s_waitcnt lgkmcnt(0)" ::: "memory")

#define XB_TMO      128
#define XB_XCNT(j)  (256  + 64 * (j))
#define XB_XSUB(j)  (1280 + 64 * (j))
#define XB_XGEN(j)  (2304 + 64 * (j))
#define XB_TOP      3328
#define XB_TOPGEN   3392
#define XCD_BAR_WORDS 3456
#define XB_SPIN_CAP (1u << 18)
DI unsigned xb_ld(unsigned* p)              { return __hip_atomic_load(p, __ATOMIC_RELAXED, __HIP_MEMORY_SCOPE_AGENT); }
DI unsigned xb_add(unsigned* p, unsigned v) { return __hip_atomic_fetch_add(p, v, __ATOMIC_RELAXED, __HIP_MEMORY_SCOPE_AGENT); }
DI unsigned xb_xcc_id() { return (unsigned)__builtin_amdgcn_s_getreg((3 << 11) | 20) & 0xFu; }
#define XB_SPIN(cond, bar) do { unsigned _sp = 0; while (cond) { __builtin_amdgcn_s_sleep(1); \
    if ((++_sp & 255u) == 0u) { if (xb_ld(&(bar)[XB_TMO])) break; if (_sp > XB_SPIN_CAP) { atomicAdd(&(bar)[XB_TMO], 1u); break; } } } } while (0)
struct XcdBarrier { unsigned* bar; unsigned x; volatile LAS unsigned* st; };
DI XcdBarrier xcd_barrier_post(unsigned* bar, volatile LAS unsigned* st) {
    XcdBarrier b; b.bar = bar; b.x = xb_xcc_id(); b.st = st;
    if (threadIdx.x == 0) (void)xb_add(&bar[XB_XCNT(b.x)], 1u);
    return b;
}
DI void xcd_barrier_complete(unsigned* bar, unsigned x, unsigned& nloc, unsigned& nx) {
    const unsigned G = gridDim.x * gridDim.y * gridDim.z;
    unsigned sum, cnt, mine, sp = 0u;
    for (;;) {
        sum = 0u; cnt = 0u; mine = 0u;
#pragma unroll
        for (unsigned j = 0; j < 16; ++j) { const unsigned c = xb_ld(&bar[XB_XCNT(j)]); sum += c; cnt += (c > 0u) ? 1u : 0u; mine = (j == x) ? c : mine; }
        if (sum == G) break;
        __builtin_amdgcn_s_sleep(1);
        if ((++sp & 255u) == 0u) { if (xb_ld(&bar[XB_TMO])) break; if (sp > XB_SPIN_CAP) { atomicAdd(&bar[XB_TMO], 1u); break; } }
    }
    nloc = mine > 0u ? mine : 1u; nx = cnt > 0u ? cnt : 1u;
}
DI void xcd_barrier(const XcdBarrier& b) {
    asm volatile("s_waitcnt vmcnt(0)" ::: "memory");
    __syncthreads();
    if (threadIdx.x == 0) {
        unsigned* bar = b.bar;
        __builtin_amdgcn_s_waitcnt(0);
        unsigned nloc = b.st[0], nx = b.st[1];
        if (nloc == 0u) { xcd_barrier_complete(bar, b.x, nloc, nx); b.st[0] = nloc; b.st[1] = nx; }
        const unsigned old = xb_add(&bar[XB_XSUB(b.x)], 1u);
        const unsigned gen = old / nloc;
        if (old + 1u == (gen + 1u) * nloc) {
            __builtin_amdgcn_fence(__ATOMIC_RELEASE, "agent");
            asm volatile("s_waitcnt vmcnt(0)" ::: "memory");
            const unsigned og = xb_add(&bar[XB_TOP], 1u);
            const unsigned tg = og / nx;
            if (og + 1u == (tg + 1u) * nx) xb_add(&bar[XB_TOPGEN], 1u);
            else XB_SPIN(xb_ld(&bar[XB_TOPGEN]) == tg, bar);
            __builtin_amdgcn_fence(__ATOMIC_ACQUIRE, "agent");
            xb_add(&bar[XB_XGEN(b.x)], 1u);
            asm volatile("s_waitcnt vmcnt(0)" ::: "memory");
        } else {
            XB_SPIN(xb_ld(&bar[XB_XGEN(b.x)]) == gen, bar);
            __builtin_amdgcn_fence(__ATOMIC_ACQUIRE, "agent");
            asm volatile("s_waitcnt vmcnt(0)" ::: "memory");
        }
    }
    __syncthreads();
}

DI void panel_sync(unsigned* cnt, unsigned expect, unsigned* tmo) {
    asm volatile("s_waitcnt vmcnt(0)" ::: "memory");
    __syncthreads();
    if (threadIdx.x == 0) {
        __builtin_amdgcn_fence(__ATOMIC_RELEASE, "agent");
        asm volatile("s_waitcnt vmcnt(0)" ::: "memory");
        (void)__hip_atomic_fetch_add(cnt, 1u, __ATOMIC_RELAXED, __HIP_MEMORY_SCOPE_AGENT);
        unsigned sp = 0;
        while (__hip_atomic_load(cnt, __ATOMIC_RELAXED, __HIP_MEMORY_SCOPE_AGENT) < expect) { __builtin_amdgcn_s_sleep(2); if (++sp > (1u << 22)) { atomicAdd(tmo, 1u); break; } }
        __builtin_amdgcn_fence(__ATOMIC_ACQUIRE, "agent");
        asm volatile("s_waitcnt vmcnt(0)" ::: "memory");
    }
    __syncthreads();
}

DI void wait_count(unsigned* cnt, unsigned expect, unsigned* tmo) {
    if (threadIdx.x == 0) {
        unsigned sp = 0;
        while (__hip_atomic_load(cnt, __ATOMIC_RELAXED, __HIP_MEMORY_SCOPE_AGENT) < expect) { __builtin_amdgcn_s_sleep(2); if (++sp > (1u << 22)) { atomicAdd(tmo, 1u); break; } }
        __builtin_amdgcn_fence(__ATOMIC_ACQUIRE, "agent");
        asm volatile("s_waitcnt vmcnt(0)" ::: "memory");
    }
    asm volatile("" ::: "memory"); __builtin_amdgcn_s_barrier(); asm volatile("" ::: "memory");
}

struct Args { const float* in[25]; float* out; unsigned char* ws; int ph_lo, ph_hi; };
struct Base { LAS unsigned char* lds; int tid, lane, wave, bid, G; };
struct Ctx {
    LAS unsigned char* lds;
    int tid, lane, wave, bid, G;
    const float *x, *c, *ctx, *c_ctx, *w_mod, *b_mod, *norm_mix, *norm_ffn, *w_in, *w_out, *q_gain, *k_gain, *na_bias, *conv_w, *conv_b,
                *lru_w_r, *lru_b_r, *lru_w_i, *lru_b_i, *lru_lambda, *router_w, *router_b, *exp_w1, *exp_w3, *exp_w2;
    float* out;
    unsigned* ctl; float* mod; float* sp8; bf16_t* gatew; bf16_t* win; bf16_t* wout; bf16_t* wup; bf16_t* wdn;
    bf16_t* hb; bf16_t* qkv; bf16_t* hid; float* xc; f32x2* agg; float* carry; int* list; f32x2* wtl; bf16_t* xb;
};
typedef const __attribute__((address_space(4))) Args* KArgsP;
DI Ctx make_ctx(const Base& B) {
    auto kp = __builtin_amdgcn_kernarg_segment_ptr();
    asm volatile("" : "+s"(kp));
    KArgsP a = (KArgsP)kp;
    Ctx X;
    int tid_ = B.tid, bid_ = B.bid, g_ = B.G;
    asm volatile("" : "+v"(tid_)); asm volatile("" : "+s"(bid_), "+s"(g_));
    X.lds = B.lds; X.tid = tid_; X.lane = tid_ & 63; X.wave = __builtin_amdgcn_readfirstlane(tid_ >> 6); X.bid = bid_; X.G = g_;
    X.x = a->in[0]; X.c = a->in[1]; X.ctx = a->in[2]; X.c_ctx = a->in[3]; X.w_mod = a->in[4]; X.b_mod = a->in[5]; X.norm_mix = a->in[6]; X.norm_ffn = a->in[7];
    X.w_in = a->in[8]; X.w_out = a->in[9]; X.q_gain = a->in[10]; X.k_gain = a->in[11]; X.na_bias = a->in[12]; X.conv_w = a->in[13]; X.conv_b = a->in[14];
    X.lru_w_r = a->in[15]; X.lru_b_r = a->in[16]; X.lru_w_i = a->in[17]; X.lru_b_i = a->in[18]; X.lru_lambda = a->in[19]; X.router_w = a->in[20]; X.router_b = a->in[21];
    X.exp_w1 = a->in[22]; X.exp_w3 = a->in[23]; X.exp_w2 = a->in[24]; X.out = a->out;
    unsigned char* ws = a->ws;
    X.ctl = (unsigned*)(ws + WS_CTL); X.mod = (float*)(ws + WS_MOD); X.sp8 = (float*)(ws + WS_SP8); X.gatew = (bf16_t*)(ws + WS_GATEW);
    X.win = (bf16_t*)(ws + WS_WIN); X.wout = (bf16_t*)(ws + WS_WOUT); X.wup = (bf16_t*)(ws + WS_WUP); X.wdn = (bf16_t*)(ws + WS_WDN);
    X.hb = (bf16_t*)(ws + WS_HB); X.qkv = (bf16_t*)(ws + WS_QKV); X.hid = (bf16_t*)(ws + WS_QKV); X.xc = (float*)(ws + WS_XC);
    X.agg = (f32x2*)(ws + WS_AGG); X.carry = (float*)(ws + WS_CARRY); X.list = (int*)(ws + WS_LIST); X.wtl = (f32x2*)(ws + WS_WTL); X.xb = (bf16_t*)(ws + WS_XB);
    return X;
}
typedef _Float16 h16x2 __attribute__((ext_vector_type(2)));
DI u32x2* ab_ptr(const Ctx& X, int row, int dir) { return row < RL ? (u32x2*)X.out + ((size_t)(row >> 1) * 2 + dir) * 512 : (u32x2*)X.xc + ((size_t)((row - RL) >> 1) * 2 + dir) * 512; }
DI int row_mb(int row) { return row < RL ? (row >> 13) : 4; }

DI void p0_transpose_item(const float* W, int K, int N, bf16_t* WT, LAS float* scr, int kb, int nb, int lane) {
    const int k0 = 64 * kb, n0 = 64 * nb, n4 = 4 * (lane & 15), kq = lane >> 4;
    f32x4 v[16];
#pragma unroll
    for (int i = 0; i < 16; ++i) v[i] = *(const f32x4*)(W + (size_t)(k0 + 4 * i + kq) * N + n0 + n4);
#pragma unroll
    for (int i = 0; i < 16; ++i) { const int k = 4 * i + kq; *(LAS f32x4*)(scr + k * 64 + (n4 ^ (((k >> 3) & 7) << 2))) = v[i]; }
    LDS_WAIT(); asm volatile("" ::: "memory");
    const int kc = lane & 7, nl = lane >> 3;
#pragma unroll
    for (int j = 0; j < 8; ++j) { const int n = nl + 8 * j; const LAS float* sp = scr + (8 * kc) * 64 + (n ^ (kc << 2));
        u32x4 o; o.x = pk2(sp[0 * 64], sp[1 * 64]); o.y = pk2(sp[2 * 64], sp[3 * 64]); o.z = pk2(sp[4 * 64], sp[5 * 64]); o.w = pk2(sp[6 * 64], sp[7 * 64]);
        *(u32x4*)(WT + (size_t)(n0 + n) * K + k0 + 8 * kc) = o; }
    LDS_WAIT(); asm volatile("" ::: "memory");
}
DI void phase_p0(const Base& B) {
    const Ctx X = make_ctx(B);
    LAS float* silu_c = (LAS float*)(X.lds);
    LAS float* red = (LAS float*)(X.lds + 32768);
    for (int i = X.tid; i < 5 * 1024; i += 512) { const int v = i >> 10, k = i & 1023; const float cv = v < 4 ? X.c[v * 1024 + k] : X.c_ctx[k]; silu_c[i] = cv / (1.0f + __expf(-cv)); }
    __syncthreads();
    for (int u = X.bid; u < DEPTH * 96; u += X.G) {
        const int l = u / 96, n0 = (u % 96) * 64, kg = X.tid >> 4, cq = X.tid & 15;
        f32x4 acc[5];
#pragma unroll
        for (int v = 0; v < 5; ++v) acc[v] = (f32x4){0.f, 0.f, 0.f, 0.f};
        const float* wp = X.w_mod + ((size_t)l * 1024 + kg * 32) * 6144 + n0 + 4 * cq;
#pragma unroll 8
        for (int k = 0; k < 32; ++k) { const f32x4 w = *(const f32x4*)(wp + (size_t)k * 6144);
#pragma unroll
            for (int v = 0; v < 5; ++v) acc[v] += w * silu_c[v * 1024 + kg * 32 + k]; }
#pragma unroll
        for (int v = 0; v < 5; ++v) *(LAS f32x4*)(red + (kg * 5 + v) * 64 + 4 * cq) = acc[v];
        __syncthreads();
        if (X.tid < 320) { const int v = X.tid >> 6, col = X.tid & 63; float s = X.b_mod[l * 6144 + n0 + col];
#pragma unroll 8
            for (int g = 0; g < 32; ++g) s += red[(g * 5 + v) * 64 + col];
            X.mod[(size_t)(l * 5 + v) * 6144 + n0 + col] = s; }
        __syncthreads();
    }
    for (int i = X.bid * 512 + X.tid; i < DEPTH * 2 * 512; i += X.G * 512) X.sp8[i] = 8.0f * log1pf(__expf(-X.lru_lambda[i]));
    __syncthreads();
    LAS float* scr = (LAS float*)(X.lds + X.wave * 16384);
    const int gw = X.bid * 8 + X.wave, NGW = X.G * 8;
    constexpr int L_ITEMS = 640 + 256 + 4096 + 2048, NITEMS = DEPTH * L_ITEMS + 128;
    for (int it = gw; it < NITEMS; it += NGW) {
        const float* W; bf16_t* WT; int K, N, kb, nb;
        if (it < DEPTH * L_ITEMS) {
            const int l = it / L_ITEMS; int r = it % L_ITEMS;
            if (r < 640) { W = X.w_in + (size_t)l * 1024 * NIN; K = 1024; N = NIN; WT = X.win + (size_t)l * NIN * 1024; kb = r / 40; nb = r % 40; }
            else if ((r -= 640) < 256) { W = X.w_out + (size_t)l * 1024 * 1024; K = 1024; N = 1024; WT = X.wout + (size_t)l * 1024 * 1024; kb = r / 16; nb = r % 16; }
            else if ((r -= 256) < 4096) { const int e = r >> 8; int q = r & 255; const int which = q >> 7; q &= 127;
                W = (which ? X.exp_w3 : X.exp_w1) + (size_t)(l * 16 + e) * 1024 * 512; K = 1024; N = 512; WT = X.wup + ((size_t)(l * 16 + e) * 1024 + which * 512) * 1024; kb = q / 8; nb = q % 8; }
            else { r -= 4096; const int e = r >> 7, q = r & 127; W = X.exp_w2 + (size_t)(l * 16 + e) * 512 * 1024; K = 512; N = 1024; WT = X.wdn + (size_t)(l * 16 + e) * 1024 * 512; kb = q / 16; nb = q % 16; }
        } else {
            const int mi = it - DEPTH * L_ITEMS; nb = 0; kb = 0; const int gate = (mi >> 3) & 1, ld = mi >> 4, blk = mi & 7;
            W = (gate ? X.lru_w_i : X.lru_w_r) + (size_t)(ld * 8 + blk) * 4096; K = 64; N = 64; WT = X.gatew + (size_t)mi * 4096;
        }
        p0_transpose_item(W, K, N, WT, scr, kb, nb, X.lane);
    }
}

template <bool BF> DI void norm1_rows(const Ctx& X, int l, int r0, int r1, int rs) {
    const int lane = X.lane;
#define CIX(j) (BF ? 8 * lane + 512 * ((j) >> 1) + 4 * ((j) & 1) : 4 * lane + 256 * (j))
#define XROWF(row) ((row) < RL ? X.x + (size_t)(row) * D : X.ctx + (size_t)((row) - RL) * D)
    f32x4 gn4[4], sc4[4], sh4[4], nv[4]; u32x4 nw[2]; int cmb = -1;
#pragma unroll
    for (int j = 0; j < 4; ++j) gn4[j] = *(const f32x4*)(X.norm_mix + l * D + CIX(j));
    if (r0 < r1) {
        if (BF) { nw[0] = *(const u32x4*)(X.xb + (size_t)r0 * D + 8 * lane); nw[1] = *(const u32x4*)(X.xb + (size_t)r0 * D + 512 + 8 * lane); }
        else {
#pragma unroll
            for (int j = 0; j < 4; ++j) nv[j] = *(const f32x4*)(XROWF(r0) + CIX(j)); } }
    for (int row = r0; row < r1; row += rs) {
        f32x4 v[4];
        if (BF) { unpack8(nw[0], v[0], v[1]); unpack8(nw[1], v[2], v[3]); }
        else {
#pragma unroll
            for (int j = 0; j < 4; ++j) v[j] = nv[j]; }
        if (row + rs < r1) {
            if (BF) { nw[0] = *(const u32x4*)(X.xb + (size_t)(row + rs) * D + 8 * lane); nw[1] = *(const u32x4*)(X.xb + (size_t)(row + rs) * D + 512 + 8 * lane); }
            else {
#pragma unroll
                for (int j = 0; j < 4; ++j) nv[j] = *(const f32x4*)(XROWF(row + rs) + CIX(j)); } }
        const int mb = row_mb(row);
        if (mb != cmb) { cmb = mb; const float* sh = X.mod + (size_t)((l * 5 + mb) * 6 + 0) * 1024;
#pragma unroll
            for (int j = 0; j < 4; ++j) { sh4[j] = *(const f32x4*)(sh + CIX(j)); sc4[j] = *(const f32x4*)(sh + 1024 + CIX(j)) + 1.0f; } }
        float s = 0.f;
#pragma unroll
        for (int j = 0; j < 4; ++j) s += (v[j].x * v[j].x + v[j].y * v[j].y) + (v[j].z * v[j].z + v[j].w * v[j].w);
        const float rsd = __builtin_amdgcn_rsqf(wave_sum(s) * (1.0f / D) + EPS);
        bf16_t* o = X.hb + (size_t)row * D;
#pragma unroll
        for (int j = 0; j < 4; ++j) { const f32x4 y = v[j] * rsd * gn4[j] * sc4[j] + sh4[j];
            u32x2 w; w.x = pk2(y.x, y.y); w.y = pk2(y.z, y.w); *(u32x2*)(o + CIX(j)) = w; }
    }
#undef CIX
#undef XROWF
}
DI bool phase_norm1(const Base& B, int l) {
    const Ctx X = make_ctx(B);
    const int nlat = X.G - NCTX_IN;
    const bool isctx = X.bid >= nlat;
    const int j = X.bid - nlat, p = j / 10, q = j % 10;
    const int r0 = isctx ? RL + 256 * p + 26 * q + X.wave : X.bid * 8 + X.wave;
    const int r1 = isctx ? (q == 9 ? RL + 256 * p + 256 : RL + 256 * p + 26 * q + 26) : RL;
    if (l == 0) norm1_rows<false>(X, l, r0, r1, isctx ? 8 : nlat * 8); else norm1_rows<true>(X, l, r0, r1, isctx ? 8 : nlat * 8);
    if (isctx) panel_sync(X.ctl + CW_PAN + (l * 4 + p) * 64, 10u, X.ctl + CW_BAR + XB_TMO);
    return isctx;
}

constexpr int BK = 64, HALF = 128, HTB = HALF * BK * 2;
DI int lds_byte(int r, int c) { return r * 128 + ((((c >> 3) ^ r) & 7) << 4) + (c & 7) * 2; }
DI void stage_rc(int b, int& Rr, int& Cc) { Rr = b >> 7; Cc = ((((b >> 4) ^ Rr) & 7)) * 8; }
DI int perm32(int rho) { const int n = rho >> 4, i = rho & 15; return 8 * (i >> 2) + 4 * n + (i & 3); }

enum { K_IN = 0, K_OUT = 1, K_UP = 2, K_DOWN = 3 };
struct GU { const char* a; const char* b; const char* bh; int i0, i1, i2, i3; };
template <int KIND> struct GK {
    static constexpr size_t A_HSTEP = KIND == K_UP ? 0 : (size_t)128 * 2048;
    static constexpr size_t B_HSTEP = KIND == K_IN ? (size_t)32 * 2048 : (KIND == K_OUT ? (size_t)128 * 2048 : (KIND == K_UP ? (size_t)512 * 2048 : (size_t)128 * 1024));
    static constexpr int KS = KIND == K_DOWN ? 8 : 16;
};

DI void cls_tables(const Ctx& X, int l) {
    LAS int* ct = (LAS int*)(X.lds + MISC_CLS);
    if (X.tid < NCLS) ct[X.tid] = (int)__hip_atomic_load(X.ctl + CW_CLS + l * 32 + X.tid, __ATOMIC_RELAXED, __HIP_MEMORY_SCOPE_AGENT);
    __syncthreads();
    if (X.tid == 0) { int tb = 0;
        for (int c = 0; c < NCLS; ++c) { ct[32 + c] = tb; tb += (ct[c] + 255) >> 8; }
        ct[32 + NCLS] = tb; }
    __syncthreads();
}
DI int cls_of_tile(const LAS int* ct, int T) { int c = 0; while (c < NCLS - 1 && T >= ct[32 + c + 1]) ++c; return c; }
DI void cls_experts(int c, int& elo, int& ehi) { const int g = c / 6, p = c % 6; const int lo = p < 3 ? 0 : (p < 5 ? 1 : 2); const int hi = p < 3 ? p + 1 : (p < 5 ? p - 1 : 3); elo = 4 * g + lo; ehi = 4 * g + hi; }

template <int KIND> DI bool gemm_unit(const Ctx& X, int l, int idx, GU& u, int mode) {
    const bool xo = (X.G == 256);
    const int x = X.bid & 7, j = idx * 32 + (X.bid >> 3);
    int un = idx * X.G + X.bid;
    if (KIND == K_IN) {
        int pm, pn;
        if (mode) { if (idx > 0) return false; un = (RL / 256) * 10 + X.bid - (X.G - NCTX_IN); pm = un / 10; pn = un % 10; }
        else if (xo) { if (j >= 160) return false;
            if (j < 128) { const int g = j >> 5, jj = j & 31; pm = 16 * x + 8 * (g & 1) + (jj >> 2); pn = 4 * (g >> 1) + (jj & 3); }
            else { const int jj = j - 128; pm = 16 * x + (jj >> 1); pn = 8 + (jj & 1); } }
        else { if (un >= (RL / 256) * 10) return false; pm = un / 10; pn = un % 10; }
        u.a = (const char*)X.hb + (size_t)pm * 256 * 2048;
        u.b = (const char*)X.win + ((size_t)l * NIN + 256 * pn) * 2048; u.bh = u.b;
        u.i0 = pm; u.i1 = pn; u.i2 = 0; u.i3 = 0; return true;
    } else if (KIND == K_OUT) {
        int pm, pn;
        if (mode) { if (idx > 0) return false; un = (RL / 256) * 4 + X.bid - (X.G - NCTX_OUT); pm = un / 4; pn = un % 4; }
        else if (xo) { if (j >= 64) return false; pm = 16 * x + 8 * (j >> 5) + ((j & 31) >> 2); pn = j & 3; }
        else { if (un >= (RL / 256) * 4) return false; pm = un / 4; pn = un % 4; }
        u.a = (const char*)X.hb + (size_t)pm * 256 * 2048;
        u.b = (const char*)X.wout + ((size_t)l * 1024 + 256 * pn) * 2048; u.bh = u.b;
        u.i0 = pm; u.i1 = pn; u.i2 = 0; u.i3 = 0; return true;
    } else if (KIND == K_UP) {
        const LAS int* ct = (const LAS int*)(X.lds + MISC_CLS);
        const int NT = ct[32 + NCLS];
        int T, pn;
        if (xo) { const int t0 = (x * NT) >> 3, t1 = ((x + 1) * NT) >> 3; if (j >= (t1 - t0) * 8) return false; T = t0 + (j >> 3); pn = j & 7; }
        else { if (un >= NT * 8) return false; T = un >> 3; pn = un & 7; }
        const int c = cls_of_tile(ct, T); int elo, ehi; cls_experts(c, elo, ehi);
        const int e = pn < 4 ? elo : ehi, pnl = pn & 3;
        u.a = (const char*)X.hb;
        u.b = (const char*)X.wup + ((size_t)(l * 16 + e) * 1024 + 128 * pnl) * 2048; u.bh = u.b;
        u.i0 = T; u.i1 = pn; u.i2 = c; u.i3 = (T - ct[32 + c]) * 256; return true;
    } else {
        const LAS int* ct = (const LAS int*)(X.lds + MISC_CLS);
        const int NT = ct[32 + NCLS];
        int T, pn;
        if (xo) { const int t0 = (x * NT) >> 3, t1 = ((x + 1) * NT) >> 3, jr = idx * 32 + 31 - (X.bid >> 3);
            if (jr >= (t1 - t0) * 4) return false; T = t0 + (jr >> 2); pn = jr & 3; }
        else { if (un >= NT * 4) return false; T = un >> 2; pn = un & 3; }
        const int c = cls_of_tile(ct, T); int elo, ehi; cls_experts(c, elo, ehi);
        u.a = (const char*)X.hid + (size_t)T * 256 * 2048;
        u.b = (const char*)X.wdn + ((size_t)(l * 16 + elo) * 1024 + 256 * pn) * 1024;
        u.bh = (const char*)X.wdn + ((size_t)(l * 16 + ehi) * 1024 + 256 * pn) * 1024 - 8 * 128;
        u.i0 = T; u.i1 = pn; u.i2 = c; u.i3 = (T - ct[32 + c]) * 256; return true;
    }
}
DI void gather_voffA(const Ctx& X, const GU& u, const int (&Rr)[2], const int (&Cc)[2], unsigned (&vo)[2][2]) {
    const LAS int* ct = (const LAS int*)(X.lds + MISC_CLS);
    const int cnt = ct[u.i2];
#pragma unroll
    for (int h = 0; h < 2; ++h)
#pragma unroll
        for (int i = 0; i < 2; ++i) { const int pos = u.i3 + 128 * h + Rr[i]; const int tok = pos < cnt ? X.list[(size_t)u.i2 * CAP + pos] : 0; vo[h][i] = (unsigned)(tok * 1024 + Cc[i]) * 2u; }
}

template <int KIND> DI void gemm_epilogue(const Ctx& X, int l, const f32x4 (&acc)[2][2][4][2], const GU& u, int wr, int wc, int fr, int fq) {
    if (KIND == K_IN) {
        const int pm = u.i0, pn = u.i1, buf = pn >> 1;
        bf16_t* O = X.qkv + (size_t)buf * (QKV_STRIDE / 2);
        const int colb = 256 * (pn & 1) + 64 * wc + 8 * fq;
        if (buf < 2) {
            const float* gp = (buf == 0 ? X.q_gain : X.k_gain) + l * 64; const float scl = buf == 0 ? QSCALE : 1.0f;
            f32x4 gv[2][2];
#pragma unroll
            for (int bj = 0; bj < 2; ++bj)
#pragma unroll
                for (int n = 0; n < 2; ++n) gv[bj][n] = *(const f32x4*)(gp + 32 * bj + 8 * fq + 4 * n) * scl;
#pragma unroll
            for (int ai = 0; ai < 2; ++ai)
#pragma unroll
                for (int m = 0; m < 4; ++m) {
                    float ss = 0.f;
#pragma unroll
                    for (int bj = 0; bj < 2; ++bj)
#pragma unroll
                        for (int n = 0; n < 2; ++n) { const f32x4 v = acc[ai][bj][m][n]; ss += (v.x * v.x + v.y * v.y) + (v.z * v.z + v.w * v.w); }
                    ss += shx<16>(ss); ss = xsum32(ss);
                    const float rs = rsqrtf(ss * (1.0f / 64.0f) + EPS);
                    bf16_t* rowp = O + (size_t)(pm * 256 + ai * 128 + wr * 64 + m * 16 + fr) * 512 + colb;
#pragma unroll
                    for (int bj = 0; bj < 2; ++bj) { const f32x4 v0 = acc[ai][bj][m][0] * gv[bj][0] * rs, v1 = acc[ai][bj][m][1] * gv[bj][1] * rs;
                        u32x4 w; w.x = pk2(v0.x, v0.y); w.y = pk2(v0.z, v0.w); w.z = pk2(v1.x, v1.y); w.w = pk2(v1.z, v1.w); *(u32x4*)(rowp + 32 * bj) = w; }
                }
        } else {
#pragma unroll
            for (int ai = 0; ai < 2; ++ai)
#pragma unroll
                for (int m = 0; m < 4; ++m) {
                    bf16_t* rowp = O + (size_t)(pm * 256 + ai * 128 + wr * 64 + m * 16 + fr) * 512 + colb;
#pragma unroll
                    for (int bj = 0; bj < 2; ++bj) { const f32x4 v0 = acc[ai][bj][m][0], v1 = acc[ai][bj][m][1];
                        u32x4 w; w.x = pk2(v0.x, v0.y); w.y = pk2(v0.z, v0.w); w.z = pk2(v1.x, v1.y); w.w = pk2(v1.z, v1.w); *(u32x4*)(rowp + 32 * bj) = w; }
                }
        }
    } else if (KIND == K_OUT) {
        const int pm = u.i0, pn = u.i1, row0 = pm * 256, mb = row_mb(row0);
        const float* gate = X.mod + (size_t)((l * 5 + mb) * 6 + 2) * 1024;
        const float* xin = row0 < RL ? X.x + (size_t)row0 * D : X.ctx + (size_t)(row0 - RL) * D;
        bf16_t* xo = X.xb + (size_t)row0 * D;
        const int col0 = 256 * pn + 32 * wc + 8 * fq;
        f32x4 gv[2][2];
#pragma unroll
        for (int bj = 0; bj < 2; ++bj)
#pragma unroll
            for (int n = 0; n < 2; ++n) gv[bj][n] = *(const f32x4*)(gate + col0 + 128 * bj + 4 * n);
#pragma unroll
        for (int ai = 0; ai < 2; ++ai)
#pragma unroll
            for (int m = 0; m < 4; ++m) { const size_t ro = (size_t)(ai * 128 + wr * 64 + m * 16 + fr) * D + col0;
#pragma unroll
                for (int bj = 0; bj < 2; ++bj) { f32x4 x0, x1;
                    if (l == 0) { x0 = *(const f32x4*)(xin + ro + 128 * bj); x1 = *(const f32x4*)(xin + ro + 128 * bj + 4); }
                    else unpack8(*(const u32x4*)(xo + ro + 128 * bj), x0, x1);
                    *(u32x4*)(xo + ro + 128 * bj) = pack8(x0 + gv[bj][0] * acc[ai][bj][m][0], x1 + gv[bj][1] * acc[ai][bj][m][1]); } }
    } else if (KIND == K_UP) {
        const int T = u.i0, pn = u.i1, c = u.i2, pos0 = u.i3, which = pn >> 2, pnl = pn & 3;
        const int col0 = 512 * which + 128 * pnl + 32 * wc + 8 * fq;
        const __amdgpu_buffer_rsrc_t hrs = __builtin_amdgcn_make_buffer_rsrc((void*)X.hid, 0, (int)((size_t)(R + NCLS * 256) * 2048), 0x00020000);
#pragma unroll
        for (int ai = 0; ai < 2; ++ai)
#pragma unroll
            for (int m = 0; m < 4; ++m) { const int lr = ai * 128 + wr * 64 + m * 16 + fr;
                const f32x2 w2 = X.wtl[(size_t)c * CAP + pos0 + lr]; const float wt = which ? w2.y : w2.x;
                float o[8];
#pragma unroll
                for (int n = 0; n < 2; ++n)
#pragma unroll
                    for (int e = 0; e < 4; ++e) { const float a = acc[ai][0][m][n][e], b = acc[ai][1][m][n][e]; o[4 * n + e] = a / (1.0f + __expf(-a)) * b * wt; }
                u32x4 w; w.x = pk2(o[0], o[1]); w.y = pk2(o[2], o[3]); w.z = pk2(o[4], o[5]); w.w = pk2(o[6], o[7]);
                __builtin_amdgcn_raw_buffer_store_b128(w, hrs, (int)(((size_t)(T * 256 + lr) * 1024 + col0) * 2), 0, 16); }
    } else {
        const int pn = u.i1, c = u.i2, pos0 = u.i3;
        const LAS int* ct = (const LAS int*)(X.lds + MISC_CLS); const int cnt = ct[c];
        const int col0 = 256 * pn + 32 * wc + 8 * fq;
#pragma unroll
        for (int ai = 0; ai < 2; ++ai)
#pragma unroll
            for (int m = 0; m < 4; ++m) { const int pos = pos0 + ai * 128 + wr * 64 + m * 16 + fr;
                if (pos < cnt) { const int tok = X.list[(size_t)c * CAP + pos]; const int mb = row_mb(tok);
                    const float* gate = X.mod + (size_t)((l * 5 + mb) * 6 + 5) * 1024 + col0; bf16_t* xo = X.xb + (size_t)tok * D + col0;
#pragma unroll
                    for (int bj = 0; bj < 2; ++bj) { f32x4 x0, x1; unpack8(*(const u32x4*)(xo + 128 * bj), x0, x1);
                        x0 += *(const f32x4*)(gate + 128 * bj) * acc[ai][bj][m][0]; x1 += *(const f32x4*)(gate + 128 * bj + 4) * acc[ai][bj][m][1];
                        if (l == DEPTH - 1) { float* of = X.out + (size_t)tok * D + col0 + 128 * bj; *(f32x4*)of = x0; *(f32x4*)(of + 4) = x1; }
                        else *(u32x4*)(xo + 128 * bj) = pack8(x0, x1); } } }
    }
}

template <int KIND, bool ALIGN_EPI> DI void gemm_phase(const Base& B, int l, int mode) {
    const Ctx X = make_ctx(B);
    if (KIND == K_UP || KIND == K_DOWN) cls_tables(X, l);
    LAS unsigned char* lds = X.lds;
    const int tid = X.tid, wid = X.wave, lane = X.lane, wr = wid >> 2, wc = wid & 3, fr = lane & 15, fq = lane >> 4;
    constexpr int nt = 16, KS = GK<KIND>::KS;
    constexpr size_t kstep = 128, ahstep = GK<KIND>::A_HSTEP, bhstep = GK<KIND>::B_HSTEP;
    int Rr[2], Cc[2]; unsigned voffB[2], voc[2][2], von[2][2];
#pragma unroll
    for (int i = 0; i < 2; ++i) { stage_rc(tid * 16 + i * 8192, Rr[i], Cc[i]);
        if (KIND == K_IN) voffB[i] = (unsigned)((64 * (Rr[i] >> 5) + perm32(Rr[i] & 31)) * 1024 + Cc[i]) * 2u;
        else if (KIND == K_DOWN) voffB[i] = (unsigned)(((Rr[i] & ~31) + perm32(Rr[i] & 31)) * 512 + Cc[i]) * 2u;
        else voffB[i] = (unsigned)(((Rr[i] & ~31) + perm32(Rr[i] & 31)) * 1024 + Cc[i]) * 2u;
        voc[0][i] = voc[1][i] = von[0][i] = von[1][i] = (unsigned)(Rr[i] * 1024 + Cc[i]) * 2u; }
    const unsigned ldsw = (unsigned)wid * 1024u;
    const int aoff = lds_byte(wr * 64 + fr, fq * 8), boff = lds_byte(wc * 32 + fr, fq * 8), aoff1 = lds_byte(wr * 64 + fr, 32 + fq * 8), boff1 = lds_byte(wc * 32 + fr, 32 + fq * 8);
#define G_SA(b, h) (((b) * 2 + (h)) * HTB)
#define G_SB(b, h) ((4 + (b) * 2 + (h)) * HTB)
#define G_STAGE(bufoff, gbase, v0, v1) do { \
        __builtin_amdgcn_global_load_lds((const unsigned*)((const char*)(gbase) + (v0)), (LAS unsigned*)(lds + (bufoff) + ldsw), 16, 0, 0); \
        __builtin_amdgcn_global_load_lds((const unsigned*)((const char*)(gbase) + (v1)), (LAS unsigned*)(lds + (bufoff) + ldsw + 8192), 16, 0, 0); } while (0)
#define G_STAGE_B(bufoff, gbase) G_STAGE(bufoff, gbase, voffB[0], voffB[1])
#define G_LDA(dst, b, h) do { _Pragma("unroll") for (int m = 0; m < 4; ++m) _Pragma("unroll") for (int k = 0; k < 2; ++k) dst[m][k] = *(const LAS bf16x8*)(lds + G_SA(b, h) + (k ? aoff1 : aoff) + m * 2048); } while (0)
#define G_LDB(dst, b, h) do { _Pragma("unroll") for (int n = 0; n < 2; ++n) _Pragma("unroll") for (int k = 0; k < 2; ++k) dst[n][k] = *(const LAS bf16x8*)(lds + G_SB(b, h) + (k ? boff1 : boff) + n * 2048); } while (0)
#define G_MMA(ai, bj, At, Bt) do { __builtin_amdgcn_s_setprio(1); _Pragma("unroll") for (int m = 0; m < 4; ++m) _Pragma("unroll") for (int n = 0; n < 2; ++n) _Pragma("unroll") for (int k = 0; k < 2; ++k) \
        acc[ai][bj][m][n] = __builtin_amdgcn_mfma_f32_16x16x32_bf16(Bt[n][k], At[m][k], acc[ai][bj][m][n], 0, 0, 0); __builtin_amdgcn_s_setprio(0); } while (0)
#define G_WAIT_V(n) asm volatile("s_waitcnt vmcnt(" #n ")" ::: "memory")
#define G_WAIT_L(n) asm volatile("s_waitcnt lgkmcnt(" #n ")" ::: "memory")
#define G_BAR __builtin_amdgcn_s_barrier()
#define G_SCHED __builtin_amdgcn_sched_barrier(0)
    GU cur, nxt; int ui = 0;
    if (!gemm_unit<KIND>(X, l, 0, cur, mode)) return;
    if (KIND == K_UP) gather_voffA(X, cur, Rr, Cc, voc);
    if (KIND == K_DOWN) wait_count(X.ctl + CW_DONE + (l * 160 + cur.i0) * 16, 8u, X.ctl + CW_BAR + XB_TMO);
    f32x4 acc[2][2][4][2];
#pragma unroll
    for (int a = 0; a < 2; ++a)
#pragma unroll
        for (int b = 0; b < 2; ++b)
#pragma unroll
            for (int m = 0; m < 4; ++m)
#pragma unroll
                for (int n = 0; n < 2; ++n) acc[a][b][m][n] = (f32x4){0.f, 0.f, 0.f, 0.f};
    bf16x8 At[4][2], B0[2][2], B1[2][2];
    const char* cA = cur.a; const char* cB = cur.b; const char* cBh = cur.bh;
    G_STAGE_B(G_SB(0, 0), cB); G_STAGE_B(G_SB(0, 1), cB + bhstep); G_STAGE(G_SA(0, 0), cA, voc[0][0], voc[0][1]); G_STAGE(G_SA(0, 1), cA + ahstep, voc[1][0], voc[1][1]);
    if (wr == 1) G_BAR;
    G_WAIT_V(2); G_BAR;
    G_STAGE_B(G_SB(1, 0), cB + kstep); G_STAGE(G_SA(1, 0), cA + kstep, voc[0][0], voc[0][1]); G_STAGE_B(G_SB(1, 1), cB + bhstep + kstep);
    G_WAIT_V(6); G_BAR;
    for (;;) {
        const bool has_next = gemm_unit<KIND>(X, l, ui + 1, nxt, mode);
        if (KIND == K_UP) { if (has_next) gather_voffA(X, nxt, Rr, Cc, von); }
        if (KIND == K_DOWN) { if (has_next) wait_count(X.ctl + CW_DONE + (l * 160 + nxt.i0) * 16, 8u, X.ctl + CW_BAR + XB_TMO); }
        const char* nA = has_next ? nxt.a : cA; const char* nB = has_next ? nxt.b : cB;
        for (int t = 0; t < nt; t += 2) {
            const bool last = (t == nt - 2);
            const char* a1 = cA + (size_t)(t + 1) * kstep;
            const char* a2 = last ? nA : cA + (size_t)(t + 2) * kstep;
            const char* b2 = last ? nB : ((t + 2) < KS ? cB : cBh) + (size_t)(t + 2) * kstep;
            const char* a3 = a2 + kstep;
            const char* b3 = last ? nB + kstep : ((t + 3) < KS ? cB : cBh) + (size_t)(t + 3) * kstep;
            unsigned v00 = voc[0][0], v01 = voc[0][1], v10 = voc[1][0], v11 = voc[1][1];
            if (KIND == K_UP) { if (last && has_next) { v00 = von[0][0]; v01 = von[0][1]; v10 = von[1][0]; v11 = von[1][1]; } }
            G_LDB(B0, 0, 0); G_LDB(B1, 0, 1); G_SCHED; G_LDA(At, 0, 0); G_STAGE(G_SA(1, 1), a1 + ahstep, voc[1][0], voc[1][1]);
            G_WAIT_V(8); G_WAIT_L(0); G_BAR; G_MMA(0, 0, At, B0); G_MMA(0, 1, At, B1); G_BAR; G_SCHED;
            G_LDA(At, 0, 1); G_STAGE_B(G_SB(0, 0), b2); G_STAGE_B(G_SB(0, 1), b2 + bhstep); G_STAGE(G_SA(0, 0), a2, v00, v01);
            G_WAIT_V(8); G_WAIT_L(0); G_BAR; G_MMA(1, 0, At, B0); G_MMA(1, 1, At, B1); G_BAR; G_SCHED;
            G_LDB(B0, 1, 0); G_LDB(B1, 1, 1); G_SCHED; G_LDA(At, 1, 0); G_STAGE(G_SA(0, 1), a2 + ahstep, v10, v11);
            G_WAIT_V(8); G_WAIT_L(0); G_BAR; G_MMA(0, 0, At, B0); G_MMA(0, 1, At, B1); G_BAR; G_SCHED;
            G_LDA(At, 1, 1); G_STAGE_B(G_SB(1, 0), b3); G_STAGE_B(G_SB(1, 1), b3 + bhstep); G_STAGE(G_SA(1, 0), a3, v00, v01);
            G_WAIT_V(8); G_WAIT_L(0); G_BAR; G_MMA(1, 0, At, B0); G_MMA(1, 1, At, B1); G_BAR; G_SCHED;
        }
        if (ALIGN_EPI) { if (wr == 0) G_BAR; }
        gemm_epilogue<KIND>(X, l, acc, cur, wr, wc, fr, fq);
        if (KIND == K_UP) {
            G_WAIT_V(0); G_BAR;
            if (tid == 0) (void)__hip_atomic_fetch_add(X.ctl + CW_DONE + (l * 160 + cur.i0) * 16, 1u, __ATOMIC_RELAXED, __HIP_MEMORY_SCOPE_AGENT); }
        if (!has_next) break;
#pragma unroll
        for (int a = 0; a < 2; ++a)
#pragma unroll
            for (int b = 0; b < 2; ++b)
#pragma unroll
                for (int m = 0; m < 4; ++m)
#pragma unroll
                    for (int n = 0; n < 2; ++n) acc[a][b][m][n] = (f32x4){0.f, 0.f, 0.f, 0.f};
        cur = nxt; cA = nxt.a; cB = nxt.b; cBh = nxt.bh; ++ui;
        if (KIND == K_UP) {
#pragma unroll
            for (int h = 0; h < 2; ++h)
#pragma unroll
                for (int i = 0; i < 2; ++i) voc[h][i] = von[h][i]; }
        if (ALIGN_EPI) { if (wr == 1) G_BAR; }
    }
    G_WAIT_V(0);
    if (!ALIGN_EPI) { if (wr == 0) G_BAR; }
    G_BAR;
#undef G_SA
#undef G_SB
#undef G_STAGE
#undef G_STAGE_B
#undef G_LDA
#undef G_LDB
#undef G_MMA
#undef G_WAIT_V
#undef G_WAIT_L
#undef G_BAR
#undef G_SCHED
}

constexpr int L_UC = 0, L_UCB = 16384, L_PRE = 24576, L_HOUT = 90112, L_SUB = 122880;
template <bool PASS2> DI void phase_lru(const Base& B, int l) {
    const Ctx X = make_ctx(B);
    LAS unsigned char* lds = X.lds;
    LAS f32x2* UC2 = (LAS f32x2*)(lds + L_UC);
    LAS bf16_t* UCB = (LAS bf16_t*)(lds + L_UCB);
    LAS f32x2* PRE2 = (LAS f32x2*)(lds + L_PRE);
    LAS f32x2* HOUT2 = (LAS f32x2*)(lds + L_HOUT);
    LAS f32x2* SUB = (LAS f32x2*)(lds + L_SUB);
    const int tid = X.tid, lane = X.lane, w = X.wave;
    const bf16_t* Ub = X.qkv + 3 * (QKV_STRIDE / 2); const bf16_t* Gb = X.qkv + 4 * (QKV_STRIDE / 2);
    const int tp = tid >> 4, c4 = tid & 15;
    const int gm = w >> 1, eh = w & 1, r32 = lane & 31, hh = lane >> 5;
    const int ch = lane, dir = w >> 2, sub = w & 3;
    const int NU = (PASS2 && l == DEPTH - 1) ? 512 * 8 : NCHUNK * 8;
    int cblk = -1; f32x4 cw[4], cbv; bf16x8 bfr[4]; float br = 0.f, bi = 0.f, sp = 0.f;
    u32x2 pu[5], pg[2]; float pc = 0.f;
#define LRU_LOAD(UN) do { const int g_ = (UN) >> 3, blk_ = (UN) & 7, tok0_ = g_ * 64; int s0_, s1_; \
        if (g_ < 512) { s0_ = (g_ >> 7) << 13; s1_ = s0_ + SEQ; } else { s0_ = RL + ((g_ - 512) >> 2) * CTX; s1_ = s0_ + CTX; } \
        _Pragma("unroll") for (int k_ = 0; k_ < 5; ++k_) { const int row_ = tok0_ + 2 * tp + k_ - 1; \
            if (row_ >= s0_ && row_ < s1_) pu[k_] = *(const u32x2*)(Ub + (size_t)row_ * 512 + blk_ * 64 + 4 * c4); else pu[k_] = (u32x2){0u, 0u}; } \
        if (PASS2) { pg[0] = *(const u32x2*)(Gb + (size_t)(tok0_ + 2 * tp) * 512 + blk_ * 64 + 4 * c4); pg[1] = *(const u32x2*)(Gb + (size_t)(tok0_ + 2 * tp + 1) * 512 + blk_ * 64 + 4 * c4); \
            pc = X.carry[(size_t)(g_ * 2 + dir) * 512 + blk_ * 64 + ch]; } } while (0)
    if (X.bid < NU) LRU_LOAD(X.bid);
    for (int un = X.bid; un < NU; un += X.G) {
        const int g = un >> 3, blk = un & 7, tok0 = g * 64;
        if (blk != cblk) { cblk = blk;
#pragma unroll
            for (int k = 0; k < 4; ++k) cw[k] = *(const f32x4*)(X.conv_w + (size_t)(l * 4 + k) * 512 + blk * 64 + 4 * c4);
            cbv = *(const f32x4*)(X.conv_b + l * 512 + blk * 64 + 4 * c4);
            const bf16_t* Wt = X.gatew + (size_t)(((l * 2 + (gm >> 1)) * 2 + (gm & 1)) * 8 + blk) * 4096;
#pragma unroll
            for (int ks = 0; ks < 4; ++ks) bfr[ks] = *(const bf16x8*)(Wt + (32 * eh + r32) * 64 + 16 * ks + 8 * hh);
            br = X.lru_b_r[(l * 2 + dir) * 512 + blk * 64 + ch]; bi = X.lru_b_i[(l * 2 + dir) * 512 + blk * 64 + ch]; sp = X.sp8[(l * 2 + dir) * 512 + blk * 64 + ch]; }
        u32x2 cu[5], cgv[2]; float cc;
#pragma unroll
        for (int k = 0; k < 5; ++k) cu[k] = pu[k];
        cgv[0] = pg[0]; cgv[1] = pg[1]; cc = pc;
        if (un + X.G < NU) LRU_LOAD(un + X.G);
        { f32x4 uf[5];
#pragma unroll
          for (int k = 0; k < 5; ++k) uf[k] = (f32x4){bflo(cu[k].x), bfhi(cu[k].x), bflo(cu[k].y), bfhi(cu[k].y)};
          f32x4 a0 = cbv, a1 = cbv;
#pragma unroll
          for (int k = 0; k < 4; ++k) { a0 += uf[k] * cw[k]; a1 += uf[k + 1] * cw[k]; }
          LAS f32x2* up = UC2 + tp * 64 + 4 * c4;
          *(LAS f32x4*)(up) = (f32x4){a0.x, a1.x, a0.y, a1.y}; *(LAS f32x4*)(up + 2) = (f32x4){a0.z, a1.z, a0.w, a1.w};
          *(LAS u32x2*)(UCB + ((c4 >> 1) * 64 + 2 * tp) * 8 + 4 * (c4 & 1)) = (u32x2){pk2(a0.x, a0.y), pk2(a0.z, a0.w)};
          *(LAS u32x2*)(UCB + ((c4 >> 1) * 64 + 2 * tp + 1) * 8 + 4 * (c4 & 1)) = (u32x2){pk2(a1.x, a1.y), pk2(a1.z, a1.w)}; }
        __syncthreads();
#pragma unroll
        for (int mb = 0; mb < 2; ++mb) { f32x16 c16;
#pragma unroll
            for (int i = 0; i < 16; ++i) c16[i] = 0.f;
#pragma unroll
            for (int ks = 0; ks < 4; ++ks) { const bf16x8 af = *(const LAS bf16x8*)(UCB + ((2 * ks + hh) * 64 + 32 * mb + r32) * 8); c16 = __builtin_amdgcn_mfma_f32_32x32x16_bf16(af, bfr[ks], c16, 0, 0, 0); }
#pragma unroll
            for (int i = 0; i < 16; i += 2) { const int tkk = 32 * mb + (i & 3) + 8 * (i >> 2) + 4 * hh;
                PRE2[(gm * 32 + (tkk >> 1)) * 64 + 32 * eh + r32] = (f32x2){c16[i], c16[i + 1]}; } }
        __syncthreads();
        float hl[16], al[16];
        { float h = 0.f, ac = 1.f; const float spl = sp * LOG2E;
          u32x2* abp = PASS2 ? nullptr : ab_ptr(X, tok0, dir) + blk * 64 + ch;
#define LRU_PAIR(DIRV, kp) do { const int tpp = (DIRV) ? (8 * sub + 7 - (kp)) : (8 * sub + (kp)); \
              const f32x2 zr = PRE2[((2 * (DIRV)) * 32 + tpp) * 64 + ch] + br, zi = PRE2[((2 * (DIRV) + 1) * 32 + tpp) * 64 + ch] + bi, uc = UC2[tpp * 64 + ch]; \
              f32x2 er = zr * (-LOG2E), ei = zi * (-LOG2E); \
              er.x = fexp2(er.x); er.y = fexp2(er.y); ei.x = fexp2(ei.x); ei.y = fexp2(ei.y); \
              er += 1.0f; ei += 1.0f; \
              f32x2 rg, ig; rg.x = frcp(er.x); rg.y = frcp(er.y); ig.x = frcp(ei.x); ig.y = frcp(ei.y); \
              f32x2 a = rg * (-spl); a.x = fexp2(a.x); a.y = fexp2(a.y); \
              const f32x2 om = 1.0f - a * a;                        \
              f32x2 bb; bb.x = __builtin_amdgcn_sqrtf(om.x); bb.y = __builtin_amdgcn_sqrtf(om.y); \
              bb = bb * ig * uc; \
              if (!PASS2) { const f32x2 oa = 1.0f - a;           \
                  abp[tpp * 1024] = (u32x2){__builtin_bit_cast(unsigned, __builtin_convertvector((f32x2){oa.x, bb.x}, h16x2)), __builtin_bit_cast(unsigned, __builtin_convertvector((f32x2){oa.y, bb.y}, h16x2))}; } \
              const float a0 = (DIRV) ? a.y : a.x, a1 = (DIRV) ? a.x : a.y, b0 = (DIRV) ? bb.y : bb.x, b1 = (DIRV) ? bb.x : bb.y; \
              h = a0 * h + b0; ac *= a0; hl[2 * (kp)] = h; al[2 * (kp)] = ac; \
              h = a1 * h + b1; ac *= a1; hl[2 * (kp) + 1] = h; al[2 * (kp) + 1] = ac; } while (0)
          if (dir == 0) {
#pragma unroll
              for (int kp = 0; kp < 8; ++kp) LRU_PAIR(0, kp); }
          else {
#pragma unroll
              for (int kp = 0; kp < 8; ++kp) LRU_PAIR(1, kp); }
#undef LRU_PAIR
          SUB[(dir * 4 + sub) * 64 + ch] = (f32x2){ac, h}; }
        __syncthreads();
        if (!PASS2) {
            if (sub == (dir ? 0 : 3)) { float S = 0.f, At = 1.f;
#pragma unroll
                for (int j = 0; j < 4; ++j) { const int sb = dir ? 3 - j : j; const f32x2 ah = SUB[(dir * 4 + sb) * 64 + ch]; S = ah.x * S + ah.y; At *= ah.x; }
                X.agg[(size_t)(g * 2 + dir) * 512 + blk * 64 + ch] = (f32x2){At, S}; }
        } else {
            float S = cc;
#pragma unroll
            for (int j = 0; j < 3; ++j) { const int sb = dir ? 3 - j : j; const bool take = dir ? (sb > sub) : (sb < sub); if (take) { const f32x2 ah = SUB[(dir * 4 + sb) * 64 + ch]; S = ah.x * S + ah.y; } }
#pragma unroll
            for (int kp = 0; kp < 8; ++kp) { const int tpp = dir ? (8 * sub + 7 - kp) : (8 * sub + kp);
                const float v0 = hl[2 * kp] + al[2 * kp] * S, v1 = hl[2 * kp + 1] + al[2 * kp + 1] * S;
                HOUT2[(dir * 32 + tpp) * 64 + ch] = dir ? (f32x2){v1, v0} : (f32x2){v0, v1}; }
            __syncthreads();
            { const LAS f32x2* hf = HOUT2 + tp * 64 + 4 * c4; const LAS f32x2* hr = HOUT2 + (32 + tp) * 64 + 4 * c4;
              const f32x4 f0 = *(const LAS f32x4*)(hf), f1 = *(const LAS f32x4*)(hf + 2), r0 = *(const LAS f32x4*)(hr), r1 = *(const LAS f32x4*)(hr + 2);
              const float sA0 = f0.x + r0.x, sB0 = f0.y + r0.y, sA1 = f0.z + r0.z, sB1 = f0.w + r0.w, sA2 = f1.x + r1.x, sB2 = f1.y + r1.y, sA3 = f1.z + r1.z, sB3 = f1.w + r1.w;
              const u32x2 gA = cgv[0], gB = cgv[1];
              u32x2 oA, oB;
              oA.x = pk2(gelu_tanh(bflo(gA.x)) * sA0, gelu_tanh(bfhi(gA.x)) * sA1); oA.y = pk2(gelu_tanh(bflo(gA.y)) * sA2, gelu_tanh(bfhi(gA.y)) * sA3);
              oB.x = pk2(gelu_tanh(bflo(gB.x)) * sB0, gelu_tanh(bfhi(gB.x)) * sB1); oB.y = pk2(gelu_tanh(bflo(gB.y)) * sB2, gelu_tanh(bfhi(gB.y)) * sB3);
              *(u32x2*)(X.hb + (size_t)(tok0 + 2 * tp) * D + 512 + blk * 64 + 4 * c4) = oA;
              *(u32x2*)(X.hb + (size_t)(tok0 + 2 * tp + 1) * D + 512 + blk * 64 + 4 * c4) = oB; }
        }
        __syncthreads();
    }
#undef LRU_LOAD
}

DI void phase_lru2(const Base& B, int l) {
    const Ctx X = make_ctx(B);
    LAS unsigned char* lds = X.lds;
    LAS f32x2* HOUT2 = (LAS f32x2*)(lds + L_HOUT);
    LAS f32x2* SUB = (LAS f32x2*)(lds + L_SUB);
    const int tid = X.tid, lane = X.lane, w = X.wave;
    const bf16_t* Gb = X.qkv + 4 * (QKV_STRIDE / 2);
    const int tp = tid >> 4, c4 = tid & 15;
    const int ch = lane, dir = w >> 2, sub = w & 3;
    const bool cx = l < DEPTH - 1;
    const int NU = cx ? NCHUNK * 8 : 512 * 8, nbl = cx ? X.G - NCTX_OUT : X.G;
    const __amdgpu_buffer_rsrc_t hrs = __builtin_amdgcn_make_buffer_rsrc((void*)X.hb, 0, (int)((size_t)R * 2048), 0x00020000);
    u32x2 pab[8]; u32x2 pg[2]; float pc = 0.f;
#define LRU2_G(UN) (cx ? (((UN) >> 3) < 16 ? 512 + ((UN) >> 3) : ((UN) >> 3) - 16) : ((UN) >> 3))
#define LRU2_LOAD(UN) do { const int g_ = LRU2_G(UN), blk_ = (UN) & 7, tok0_ = g_ * 64; \
        { const u32x2* ap_ = ab_ptr(X, tok0_, dir) + blk_ * 64 + ch; _Pragma("unroll") for (int k_ = 0; k_ < 8; ++k_) pab[k_] = ap_[(dir ? 8 * sub + 7 - k_ : 8 * sub + k_) * 1024]; } \
        pg[0] = *(const u32x2*)(Gb + (size_t)(tok0_ + 2 * tp) * 512 + blk_ * 64 + 4 * c4); pg[1] = *(const u32x2*)(Gb + (size_t)(tok0_ + 2 * tp + 1) * 512 + blk_ * 64 + 4 * c4); \
        pc = X.carry[(size_t)(g_ * 2 + dir) * 512 + blk_ * 64 + ch]; } while (0)
    if (X.bid < NU) LRU2_LOAD(X.bid);
    for (int un = X.bid; un < NU; un += nbl) {
        const int g = LRU2_G(un), blk = un & 7, tok0 = g * 64;
        u32x2 cab[8]; u32x2 cgv[2]; float cc;
#pragma unroll
        for (int k = 0; k < 8; ++k) cab[k] = pab[k];
        cgv[0] = pg[0]; cgv[1] = pg[1]; cc = pc;
        if (un + nbl < NU) LRU2_LOAD(un + nbl);
        float hl[16], al[16];
        { float h = 0.f, ac = 1.f;
#pragma unroll
          for (int kp = 0; kp < 8; ++kp) {
              const unsigned w0 = dir ? cab[kp].y : cab[kp].x, w1 = dir ? cab[kp].x : cab[kp].y;
              const h16x2 f0 = __builtin_bit_cast(h16x2, w0), f1 = __builtin_bit_cast(h16x2, w1);
              const float a0 = 1.0f - (float)f0.x, a1 = 1.0f - (float)f1.x;
              h = a0 * h + (float)f0.y; ac *= a0; hl[2 * kp] = h; al[2 * kp] = ac;
              h = a1 * h + (float)f1.y; ac *= a1; hl[2 * kp + 1] = h; al[2 * kp + 1] = ac; }
          SUB[(dir * 4 + sub) * 64 + ch] = (f32x2){ac, h}; }
        __syncthreads();
        { float S = cc;
#pragma unroll
          for (int j = 0; j < 3; ++j) { const int sb = dir ? 3 - j : j; const bool take = dir ? (sb > sub) : (sb < sub); if (take) { const f32x2 ah = SUB[(dir * 4 + sb) * 64 + ch]; S = ah.x * S + ah.y; } }
#pragma unroll
          for (int kp = 0; kp < 8; ++kp) { const int tpp = dir ? (8 * sub + 7 - kp) : (8 * sub + kp);
              const float v0 = hl[2 * kp] + al[2 * kp] * S, v1 = hl[2 * kp + 1] + al[2 * kp + 1] * S;
              HOUT2[(dir * 32 + tpp) * 64 + ch] = dir ? (f32x2){v1, v0} : (f32x2){v0, v1}; } }
        __syncthreads();
        { const LAS f32x2* hf = HOUT2 + tp * 64 + 4 * c4; const LAS f32x2* hr = HOUT2 + (32 + tp) * 64 + 4 * c4;
          const f32x4 f0 = *(const LAS f32x4*)(hf), f1 = *(const LAS f32x4*)(hf + 2), r0 = *(const LAS f32x4*)(hr), r1 = *(const LAS f32x4*)(hr + 2);
          const float sA0 = f0.x + r0.x, sB0 = f0.y + r0.y, sA1 = f0.z + r0.z, sB1 = f0.w + r0.w, sA2 = f1.x + r1.x, sB2 = f1.y + r1.y, sA3 = f1.z + r1.z, sB3 = f1.w + r1.w;
          const u32x2 gA = cgv[0], gB = cgv[1];
          u32x2 oA, oB;
          oA.x = pk2(gelu_tanh(bflo(gA.x)) * sA0, gelu_tanh(bfhi(gA.x)) * sA1); oA.y = pk2(gelu_tanh(bflo(gA.y)) * sA2, gelu_tanh(bfhi(gA.y)) * sA3);
          oB.x = pk2(gelu_tanh(bflo(gB.x)) * sB0, gelu_tanh(bfhi(gB.x)) * sB1); oB.y = pk2(gelu_tanh(bflo(gB.y)) * sB2, gelu_tanh(bfhi(gB.y)) * sB3);
          if (g >= 512) {
              __builtin_amdgcn_raw_buffer_store_b64(oA, hrs, (int)(((size_t)(tok0 + 2 * tp) * D + 512 + blk * 64 + 4 * c4) * 2), 0, 16);
              __builtin_amdgcn_raw_buffer_store_b64(oB, hrs, (int)(((size_t)(tok0 + 2 * tp + 1) * D + 512 + blk * 64 + 4 * c4) * 2), 0, 16);
              asm volatile("s_waitcnt vmcnt(0)" ::: "memory"); }
          else { *(u32x2*)(X.hb + (size_t)(tok0 + 2 * tp) * D + 512 + blk * 64 + 4 * c4) = oA;
                 *(u32x2*)(X.hb + (size_t)(tok0 + 2 * tp + 1) * D + 512 + blk * 64 + 4 * c4) = oB; } }
        __syncthreads();
        if (g >= 512 && tid == 0) (void)__hip_atomic_fetch_add(X.ctl + CW_ECTX + l * 64, 1u, __ATOMIC_RELAXED, __HIP_MEMORY_SCOPE_AGENT);
    }
#undef LRU2_LOAD
#undef LRU2_G
}

DI void carry_prop(const Ctx& X, int cb) {
    LAS f32x2* XS = (LAS f32x2*)(X.lds);
    const int pi = cb >> 2, b = pi >> 1, dir = pi & 1, seg = X.tid >> 7, ch = 128 * (cb & 3) + (X.tid & 127);
    f32x2 cx[4], ah[32];
#pragma unroll
    for (int j = 0; j < 4; ++j) { const int c = dir ? 3 - j : j, g = 512 + 4 * b + c; cx[j] = X.agg[(size_t)(g * 2 + dir) * 512 + ch]; }
#pragma unroll
    for (int k = 0; k < 32; ++k) { const int j = 32 * seg + k, c = dir ? 127 - j : j, g = 128 * b + c; ah[k] = X.agg[(size_t)(g * 2 + dir) * 512 + ch]; }
    float S = 0.f;
#pragma unroll
    for (int j = 0; j < 4; ++j) { const int c = dir ? 3 - j : j, g = 512 + 4 * b + c; if (seg == 0) X.carry[(size_t)(g * 2 + dir) * 512 + ch] = S; S = cx[j].x * S + cx[j].y; }
    float As = 1.f, Hs = 0.f;
#pragma unroll
    for (int k = 0; k < 32; ++k) { Hs = ah[k].x * Hs + ah[k].y; As *= ah[k].x; }
    XS[seg * 128 + (X.tid & 127)] = (f32x2){As, Hs};
    __syncthreads();
#pragma unroll
    for (int sp = 0; sp < 3; ++sp) if (sp < seg) { const f32x2 t = XS[sp * 128 + (X.tid & 127)]; S = t.x * S + t.y; }
#pragma unroll
    for (int k = 0; k < 32; ++k) { const int j = 32 * seg + k, c = dir ? 127 - j : j, g = 128 * b + c; X.carry[(size_t)(g * 2 + dir) * 512 + ch] = S; S = ah[k].x * S + ah[k].y; }
    __syncthreads();
}
DI int row0_of(int r) { const int v = r - 4; return v < 0 ? 0 : (v > 120 ? 120 : v); }
constexpr int A_STG = 32768, A_NSTG = 4, A_TBL = LDS_MISC + 4096;
#define ATT_SOFTMAX1(P)  do { float ps_ = 0.f, pt_ = 0.f; \
        _Pragma("unroll") for (int i_ = 0; i_ < 16; i_ += 2) { P[i_] = fexp2(P[i_]); P[i_ + 1] = fexp2(P[i_ + 1]); ps_ += P[i_]; pt_ += P[i_ + 1]; } \
        lrun += ps_ + pt_; } while (0)
#define ATT_PACK(P, sx) __builtin_bit_cast(bf16x8, (u32x4){pk2(P[8 * (sx)], P[8 * (sx) + 1]), pk2(P[8 * (sx) + 2], P[8 * (sx) + 3]), pk2(P[8 * (sx) + 4], P[8 * (sx) + 5]), pk2(P[8 * (sx) + 6], P[8 * (sx) + 7])})
#define ATT_DMA1(dstoff, ktok) do { const bf16_t* kb_ = Kb + (size_t)(ktok) * 512 + 64 * h; const bf16_t* vb_ = Vb + (size_t)(ktok) * 512 + 64 * h; \
        __builtin_amdgcn_global_load_lds((const unsigned*)(kb_ + kso), (LAS unsigned*)(lds + (dstoff) + w * 1024), 16, 0, 0); \
        __builtin_amdgcn_global_load_lds((const unsigned*)(vb_ + vso), (LAS unsigned*)(lds + (dstoff) + 8192 + w * 1024), 16, 0, 0); } while (0)
#define ATT_PTOK(P, j) ((P) < nwp ? (b * SEQ + 64 * (krlo + ((2 * (P) + (j)) < nwin ? (2 * (P) + (j)) : nwin - 1))) : (RL + b * CTX + 64 * (2 * ((P) - nwp) + (j))))
#define ATT_DMAP(stage, P) do { ATT_DMA1((stage) * A_STG, ATT_PTOK(P, 0)); ATT_DMA1((stage) * A_STG + 16384, ATT_PTOK(P, 1)); } while (0)
#define ATT_VREAD(VB, IMM0, VL, VH) do { \
        _Pragma("unroll") for (int db_ = 0; db_ < 2; ++db_) _Pragma("unroll") for (int sx_ = 0; sx_ < 2; ++sx_) { \
            asm volatile("ds_read_b64_tr_b16 %0, %1 offset:%c2" : "=&v"(VL[db_][sx_]) : "v"(VB), "i"((IMM0) + db_ * 4096 + sx_ * 1024) : "memory"); \
            asm volatile("ds_read_b64_tr_b16 %0, %1 offset:%c2" : "=&v"(VH[db_][sx_]) : "v"(VB), "i"((IMM0) + db_ * 4096 + sx_ * 1024 + 512) : "memory"); } } while (0)
#define ATT_LGKM0() do { asm volatile("s_waitcnt lgkmcnt(0)" ::: "memory"); __builtin_amdgcn_sched_barrier(0); } while (0)
#define ATT_PVMMA(VL, VH, PF0, PF1) do { \
        _Pragma("unroll") for (int sx_ = 0; sx_ < 2; ++sx_) { \
            const bf16x8 va_ = (bf16x8){VL[0][sx_][0], VL[0][sx_][1], VL[0][sx_][2], VL[0][sx_][3], VH[0][sx_][0], VH[0][sx_][1], VH[0][sx_][2], VH[0][sx_][3]}; \
            const bf16x8 vb_ = (bf16x8){VL[1][sx_][0], VL[1][sx_][1], VL[1][sx_][2], VL[1][sx_][3], VH[1][sx_][0], VH[1][sx_][1], VH[1][sx_][2], VH[1][sx_][3]}; \
            o0 = __builtin_amdgcn_mfma_f32_32x32x16_bf16(va_, sx_ ? (PF1) : (PF0), o0, 0, 0, 0); o1 = __builtin_amdgcn_mfma_f32_32x32x16_bf16(vb_, sx_ ? (PF1) : (PF0), o1, 0, 0, 0); } } while (0)
template <int ST> DI void att_step(LAS unsigned char* lds, int sp, int npairs, int nwp, int nwin, int krlo, int wlo, int whi, int myr0, int qrow, int cs, int r32, int hh, unsigned vwin, unsigned vctx, unsigned kwin, unsigned kctx,
                                   unsigned kso, unsigned vso, int w, int h, int b, const bf16_t* Kb, const bf16_t* Vb, const LAS float* TBL, const unsigned (&bp)[4], const bf16x8 (&qf)[4],
                                   f32x16& o0, f32x16& o1, float mref, float& lrun) {
    const int rem = npairs - 1 - sp;
    if (rem >= 2) asm volatile("s_waitcnt vmcnt(8) lgkmcnt(0)" ::: "memory"); else if (rem == 1) asm volatile("s_waitcnt vmcnt(4) lgkmcnt(0)" ::: "memory"); else asm volatile("s_waitcnt vmcnt(0) lgkmcnt(0)" ::: "memory");
    __builtin_amdgcn_s_barrier(); asm volatile("" ::: "memory");
    if (sp + 3 < npairs) ATT_DMAP((ST + 3) & 3, sp + 3);
    const unsigned vhi = (ST >= 2 ? 65536u : 0u); constexpr int IMM = (ST & 1) * A_STG + 8192;
    constexpr int KIMM = (ST & 1) * A_STG;
    const unsigned kw = kwin + vhi, kc = kctx + vhi;
#define ATT_KF(base, off) (*(const LAS bf16x8*)(size_t)((base) + (unsigned)(KIMM + (off))))
    if (sp < nwp) {
        unsigned b4[16];
        { unsigned w0 = bp[0], w1 = bp[1], w2 = bp[2], w3 = bp[3]; asm volatile("" : "+v"(w0), "+v"(w1), "+v"(w2), "+v"(w3));
#pragma unroll
          for (int i = 0; i < 16; ++i) { const unsigned wv = (i >> 2) == 0 ? w0 : ((i >> 2) == 1 ? w1 : ((i >> 2) == 2 ? w2 : w3)); b4[i] = (wv >> (8 * (i & 3))) & 0xffu; } }
#define ATT_TB(row, i) (*(const LAS float*)((const LAS unsigned char*)(row) + b4[i]))
        const int kr0 = krlo + 2 * sp, kr1 = kr0 + 1;
        const bool a0 = kr0 >= wlo && kr0 <= whi, a1 = (2 * sp + 1 < nwin) && kr1 >= wlo && kr1 <= whi;
        if (a0 && a1) {
            const int ri0 = (kr0 >= myr0 && kr0 < myr0 + 8) ? (kr0 - qrow + 7) : 15, ri1 = (kr1 >= myr0 && kr1 < myr0 + 8) ? (kr1 - qrow + 7) : 15;
            const LAS float* tr0 = TBL + ri0 * 32; const LAS float* tr1 = TBL + ri1 * 32;
            f32x16 pa, pb; bf16x8 ka[4], kb2[4]; s16x4 vla[2][2], vha[2][2], vlb[2][2], vhb[2][2];
#pragma unroll
            for (int i = 0; i < 16; ++i) { pa[i] = ATT_TB(tr0, i); pb[i] = ATT_TB(tr1, i); }
#pragma unroll
            for (int ks = 0; ks < 4; ++ks) { ka[ks] = ATT_KF(kw, 2 * ks * 1024); kb2[ks] = ATT_KF(kw, 16384 + 2 * ks * 1024); }
            ATT_VREAD(vwin + vhi, IMM, vla, vha);
            ATT_VREAD(vwin + vhi, IMM + 16384, vlb, vhb);
            ATT_LGKM0();
#pragma unroll
            for (int ks = 0; ks < 4; ++ks) { pa = __builtin_amdgcn_mfma_f32_32x32x16_bf16(ka[ks], qf[ks], pa, 0, 0, 0); pb = __builtin_amdgcn_mfma_f32_32x32x16_bf16(kb2[ks], qf[ks], pb, 0, 0, 0); }
            ATT_SOFTMAX1(pa);
            { const bf16x8 pf0 = ATT_PACK(pa, 0), pf1 = ATT_PACK(pa, 1); ATT_PVMMA(vla, vha, pf0, pf1); }
            ATT_SOFTMAX1(pb);
            { const bf16x8 pf0 = ATT_PACK(pb, 0), pf1 = ATT_PACK(pb, 1); ATT_PVMMA(vlb, vhb, pf0, pf1); }
        } else if (a0 || a1) {
            const int kr = a0 ? kr0 : kr1; const unsigned jo = a0 ? 0u : 16384u;
            const int ri = (kr >= myr0 && kr < myr0 + 8) ? (kr - qrow + 7) : 15;
            const LAS float* trow = TBL + ri * 32;
            f32x16 p; bf16x8 kf[4]; s16x4 vl[2][2], vh[2][2];
#pragma unroll
            for (int i = 0; i < 16; ++i) p[i] = ATT_TB(trow, i);
#pragma unroll
            for (int ks = 0; ks < 4; ++ks) kf[ks] = ATT_KF(kw + jo, 2 * ks * 1024);
            ATT_VREAD(vwin + vhi + jo, IMM, vl, vh);
            ATT_LGKM0();
#pragma unroll
            for (int ks = 0; ks < 4; ++ks) p = __builtin_amdgcn_mfma_f32_32x32x16_bf16(kf[ks], qf[ks], p, 0, 0, 0);
            ATT_SOFTMAX1(p);
            const bf16x8 pf0 = ATT_PACK(p, 0), pf1 = ATT_PACK(p, 1);
            ATT_PVMMA(vl, vh, pf0, pf1);
        }
    } else {
        float nm = -mref; asm volatile("" : "+v"(nm));
#pragma unroll
        for (int j = 0; j < 2; ++j) {
            f32x16 pa, pb; bf16x8 ka[4], kb2[4]; s16x4 vla[2][2], vha[2][2], vlb[2][2], vhb[2][2];
#pragma unroll
            for (int ks = 0; ks < 4; ++ks) { ka[ks] = ATT_KF(kc, j * 16384 + 2 * ks * 1024); kb2[ks] = ATT_KF(kc, j * 16384 + 2 * ks * 1024 + 512); }
            ATT_VREAD(vctx + vhi, IMM + j * 16384, vla, vha);
            ATT_VREAD(vctx + vhi, IMM + j * 16384 + 2048, vlb, vhb);
            ATT_LGKM0();
#pragma unroll
            for (int i = 0; i < 16; ++i) { pa[i] = nm; pb[i] = nm; }
#pragma unroll
            for (int ks = 0; ks < 4; ++ks) { pa = __builtin_amdgcn_mfma_f32_32x32x16_bf16(ka[ks], qf[ks], pa, 0, 0, 0); pb = __builtin_amdgcn_mfma_f32_32x32x16_bf16(kb2[ks], qf[ks], pb, 0, 0, 0); }
            ATT_SOFTMAX1(pa);
            { const bf16x8 pf0 = ATT_PACK(pa, 0), pf1 = ATT_PACK(pa, 1); ATT_PVMMA(vla, vha, pf0, pf1); }
            ATT_SOFTMAX1(pb);
            { const bf16x8 pf0 = ATT_PACK(pb, 0), pf1 = ATT_PACK(pb, 1); ATT_PVMMA(vlb, vhb, pf0, pf1); }
        }
    }
}
#undef ATT_KF
#undef ATT_TB
DI void phase_attn(const Base& B, int l) {
    const Ctx X = make_ctx(B);
    if (X.bid >= X.G - 32) carry_prop(X, X.bid - (X.G - 32));
    LAS unsigned char* lds = X.lds;
    LAS float* TBL = (LAS float*)(lds + A_TBL);
    const int tid = X.tid, lane = X.lane, w = X.wave, r32 = lane & 31, hh = lane >> 5;
    const bf16_t* Qb = X.qkv; const bf16_t* Kb = X.qkv + (QKV_STRIDE / 2); const bf16_t* Vb = X.qkv + 2 * (QKV_STRIDE / 2);
    const int nunits = (l == DEPTH - 1) ? 1024 : 1056;
    const unsigned kso = (unsigned)(lane * 512 + 8 * w), vso = (unsigned)((16 * (w & 3) + (lane >> 2)) * 512 + 32 * (w >> 2) + 8 * (lane & 3));
    const unsigned vlane = (unsigned)((4 * hh + ((lane & 15) >> 2)) * 64 + (16 * ((lane >> 4) & 1) + 4 * (lane & 3)) * 2);
    const unsigned ldsb = (unsigned)(size_t)lds;
    const int rp = w >> 2, jb = w & 3, qcol = 16 * jb + (r32 & 15);
    int cs = 16 * jb - 8; cs = cs < 0 ? 0 : (cs > 32 ? 32 : cs);
    unsigned bp[4] = {0u, 0u, 0u, 0u};
    { int c0 = qcol - 8; c0 = c0 < 0 ? 0 : (c0 > 48 ? 48 : c0);
#pragma unroll
      for (int i = 0; i < 16; ++i) { const int kc = cs + (i & 3) + 8 * (i >> 2) + 4 * hh; const int bi = (kc >= c0 && kc < c0 + 16) ? (kc - qcol + 15) : 31; bp[i >> 2] |= (unsigned)(bi * 4) << (8 * (i & 3)); } }
    const unsigned vctx = ldsb + vlane, vwin = vctx + (unsigned)cs * 64u;
    const unsigned kctx = ldsb + (unsigned)(hh * 1024 + r32 * 16), kwin = kctx + (unsigned)cs * 16u;
    float mref;
    { float gq = fabsf(X.q_gain[l * 64 + lane]), gk = fabsf(X.k_gain[l * 64 + lane]);
      gq = fmaxf(gq, shx<1>(gq)); gk = fmaxf(gk, shx<1>(gk)); gq = fmaxf(gq, shx<2>(gq)); gk = fmaxf(gk, shx<2>(gk)); gq = fmaxf(gq, shx<4>(gq)); gk = fmaxf(gk, shx<4>(gk));
      gq = fmaxf(gq, shx<8>(gq)); gk = fmaxf(gk, shx<8>(gk)); gq = fmaxf(gq, shx<16>(gq)); gk = fmaxf(gk, shx<16>(gk)); gq = xmax32(gq); gk = xmax32(gk);
      mref = 8.0f * LOG2E * gq * gk; }
    int tbl_h = -1;
    for (int un = X.bid; un < nunits; un += X.G) {
        const bool lat = un < 1024;
        int b, h, r0 = 0;
        if (lat) { b = un >> 8; h = (un >> 5) & 7; r0 = 4 * (un & 31); } else { const int v = un - 1024; b = v >> 3; h = v & 7; }
        int krlo = 0, nwin = 0, qrow = 0, myr0 = 0, wlo = 0, whi = 0, qtok;
        if (lat) { krlo = row0_of(r0); nwin = row0_of(r0 + 3) + 8 - krlo; const int ra = r0 + 2 * rp; qrow = ra + (r32 >> 4); myr0 = row0_of(qrow); wlo = row0_of(ra); whi = row0_of(ra + 1) + 7;
            qtok = b * SEQ + 64 * qrow + qcol; }
        else qtok = RL + b * CTX + 32 * w + r32;
        const int nwp = (nwin + 1) >> 1, npairs = nwp + 2;
        ATT_DMAP(0, 0); ATT_DMAP(1, 1); if (npairs > 2) ATT_DMAP(2, 2);
        if (lat && h != tbl_h) { tbl_h = h;
            for (int i = tid; i < 16 * 32; i += 512) { const int ri = i >> 5, ci = i & 31; TBL[i] = (ci < 31 && ri < 15) ? X.na_bias[((size_t)(l * 8 + h) * 15 + ri) * 31 + ci] * LOG2E - mref : NEGBIG; } }
        bf16x8 qf[4];
#pragma unroll
        for (int ks = 0; ks < 4; ++ks) qf[ks] = *(const bf16x8*)(Qb + (size_t)qtok * 512 + 64 * h + 16 * ks + 8 * hh);
        f32x16 o0, o1;
#pragma unroll
        for (int i = 0; i < 16; ++i) { o0[i] = 0.f; o1[i] = 0.f; }
        float lrun = 0.f;
#define ATT_STEP(ST, sv) att_step<ST>(lds, sv, npairs, nwp, nwin, krlo, wlo, whi, myr0, qrow, cs, r32, hh, vwin, vctx, kwin, kctx, kso, vso, w, h, b, Kb, Vb, TBL, bp, qf, o0, o1, mref, lrun)
        for (int s0 = 0; s0 < npairs; s0 += 4) {
            ATT_STEP(0, s0);
            if (s0 + 1 < npairs) ATT_STEP(1, s0 + 1);
            if (s0 + 2 < npairs) ATT_STEP(2, s0 + 2);
            if (s0 + 3 < npairs) ATT_STEP(3, s0 + 3);
        }
#undef ATT_STEP
        asm volatile("" ::: "memory"); __builtin_amdgcn_s_barrier(); asm volatile("" ::: "memory");
        { const float lt = xsum32(lrun), inv = frcp(lt);
          bf16_t* op = X.hb + (size_t)qtok * D + 64 * h + 4 * hh;
#pragma unroll
          for (int gq = 0; gq < 4; ++gq) { u32x2 a, c; a.x = pk2(o0[4 * gq] * inv, o0[4 * gq + 1] * inv); a.y = pk2(o0[4 * gq + 2] * inv, o0[4 * gq + 3] * inv);
              c.x = pk2(o1[4 * gq] * inv, o1[4 * gq + 1] * inv); c.y = pk2(o1[4 * gq + 2] * inv, o1[4 * gq + 3] * inv);
              *(u32x2*)(op + 8 * gq) = a; *(u32x2*)(op + 32 + 8 * gq) = c; } }
    }
}
#undef ATT_SOFTMAX1
#undef ATT_PACK
#undef ATT_VREAD
#undef ATT_LGKM0
#undef ATT_PVMMA
#undef ATT_DMA1
#undef ATT_PTOK
#undef ATT_DMAP

constexpr int G_RWP = 1032, G_RWH = 0, G_RWL = G_RWH + 16 * G_RWP * 2, G_GM = G_RWL + 16 * G_RWP * 2, G_SH = G_GM + 5 * 1024 * 4, G_LG = G_SH + 5 * 1024 * 4,
              G_SELC = G_LG + 272 * 16 * 4, G_SELW = G_SELC + 272 * 4, G_CNT = G_SELW + 272 * 8, G_BASE = G_CNT + 128;
static_assert(G_BASE + 128 <= LDS_MISC, "router LDS map");
DI void phase_router(const Base& B, int l, int dummy) {
    Ctx X = make_ctx(B);
    if (dummy) { X.list += 13 * (MiB / 4); X.wtl += 13 * (MiB / 8); }
    const int cwc = CW_CLS + (dummy ? 128 : 0) + l * 32;
    LAS unsigned char* lds = X.lds;
    LAS bf16_t* RWH = (LAS bf16_t*)(lds + G_RWH); LAS bf16_t* RWL = (LAS bf16_t*)(lds + G_RWL);
    LAS float* GM = (LAS float*)(lds + G_GM); LAS float* SHT = (LAS float*)(lds + G_SH);
    LAS float* LG = (LAS float*)(lds + G_LG);
    LAS int* SELC = (LAS int*)(lds + G_SELC);
    LAS f32x2* SELW = (LAS f32x2*)(lds + G_SELW);
    LAS int* CNT = (LAS int*)(lds + G_CNT); LAS int* BASE = (LAS int*)(lds + G_BASE);
    const int tid = X.tid, lane = X.lane, w = X.wave;
    for (int i = tid; i < 16384; i += 512) { const float wv = X.router_w[i]; const unsigned hi = pk2(wv, 0.f) & 0xffffu; const unsigned lo = pk2(wv - bflo(hi), 0.f) & 0xffffu;
        RWH[(i & 15) * G_RWP + (i >> 4)] = (bf16_t)hi; RWL[(i & 15) * G_RWP + (i >> 4)] = (bf16_t)lo; }
    for (int i = tid; i < 5 * 1024; i += 512) { const int mb = i >> 10, c = i & 1023; const float* sh = X.mod + (size_t)((l * 5 + mb) * 6 + 3) * 1024;
        GM[i] = X.norm_ffn[l * D + c] * (sh[1024 + c] + 1.0f); SHT[i] = sh[c]; }
    if (tid < 32) CNT[tid] = 0;
    __syncthreads();
    int row0, nrows;
    { const int NG = (l < DEPTH - 1 ? R : RL) / 16, g0 = (int)(((long)X.bid * NG) / X.G), g1 = (int)(((long)(X.bid + 1) * NG) / X.G); row0 = 16 * g0; nrows = 16 * (g1 - g0); }
    const int r16 = lane & 15, kb = lane >> 4;
    for (int gi = w; gi * 16 < nrows; gi += 8) {
        const int rl = gi * 16 + r16; const bool valid = rl < nrows; const int row = row0 + (valid ? rl : nrows - 1), mb = row_mb(row);
        const bf16_t* xr = X.xb + (size_t)row * D + 8 * kb;
        float ss = 0.f;
#pragma unroll
        for (int c0 = 0; c0 < 32; c0 += 8) { u32x4 raw[8];
#pragma unroll
            for (int c = 0; c < 8; ++c) raw[c] = *(const u32x4*)(xr + 32 * (c0 + c));
#pragma unroll
            for (int c = 0; c < 8; ++c) { f32x4 a, b; unpack8(raw[c], a, b); ss += ((a.x * a.x + a.y * a.y) + (a.z * a.z + a.w * a.w)) + ((b.x * b.x + b.y * b.y) + (b.z * b.z + b.w * b.w)); } }
        ss += shx<16>(ss); ss = xsum32(ss);
        const float rsd = __builtin_amdgcn_rsqf(ss * (1.0f / D) + EPS);
        bf16_t* orow = X.hb + (size_t)row * D + 8 * kb;
        const LAS float* gmr = GM + mb * 1024 + 8 * kb; const LAS float* shr = SHT + mb * 1024 + 8 * kb;
        const LAS bf16_t* bhp = RWH + r16 * G_RWP + 8 * kb; const LAS bf16_t* blp = RWL + r16 * G_RWP + 8 * kb;
        f32x4 dacc = (f32x4){0.f, 0.f, 0.f, 0.f};
#pragma unroll
        for (int c0 = 0; c0 < 32; c0 += 8) { u32x4 raw[8];
#pragma unroll
            for (int c = 0; c < 8; ++c) raw[c] = *(const u32x4*)(xr + 32 * (c0 + c));
#pragma unroll
            for (int cc = 0; cc < 8; ++cc) { const int c = c0 + cc; f32x4 a, b; unpack8(raw[cc], a, b);
                const f32x4 g0 = *(const LAS f32x4*)(gmr + 32 * c), g1 = *(const LAS f32x4*)(gmr + 32 * c + 4), h0 = *(const LAS f32x4*)(shr + 32 * c), h1 = *(const LAS f32x4*)(shr + 32 * c + 4);
                const f32x4 y0 = a * rsd * g0 + h0, y1 = b * rsd * g1 + h1;
                const u32x4 hw = pack8(y0, y1);
                if (valid) *(u32x4*)(orow + 32 * c) = hw;
                f32x4 q0, q1; unpack8(hw, q0, q1);
                const u32x4 lw = pack8(y0 - q0, y1 - q1);
                const bf16x8 bh = *(const LAS bf16x8*)(bhp + 32 * c), bl = *(const LAS bf16x8*)(blp + 32 * c);
                const bf16x8 ah = __builtin_bit_cast(bf16x8, hw), al = __builtin_bit_cast(bf16x8, lw);
                dacc = __builtin_amdgcn_mfma_f32_16x16x32_bf16(ah, bh, dacc, 0, 0, 0);
                dacc = __builtin_amdgcn_mfma_f32_16x16x32_bf16(al, bh, dacc, 0, 0, 0);
                dacc = __builtin_amdgcn_mfma_f32_16x16x32_bf16(ah, bl, dacc, 0, 0, 0); }
            asm volatile("" : "+v"(dacc) : : "memory"); }
#pragma unroll
        for (int i = 0; i < 4; ++i) { const int rr = gi * 16 + 4 * kb + i; if (rr < nrows) LG[rr * 16 + r16] = dacc[i]; }
    }
    __syncthreads();
    if (tid < nrows) {
        float aff[16], sel[16];
#pragma unroll
        for (int q = 0; q < 4; ++q) { const f32x4 t4 = *(const LAS f32x4*)(LG + tid * 16 + 4 * q); const f32x4 rb4 = *(const f32x4*)(X.router_b + 4 * q);
            aff[4 * q] = sigmoidf_(t4.x); aff[4 * q + 1] = sigmoidf_(t4.y); aff[4 * q + 2] = sigmoidf_(t4.z); aff[4 * q + 3] = sigmoidf_(t4.w);
            sel[4 * q] = aff[4 * q] + rb4.x; sel[4 * q + 1] = aff[4 * q + 1] + rb4.y; sel[4 * q + 2] = aff[4 * q + 2] + rb4.z; sel[4 * q + 3] = aff[4 * q + 3] + rb4.w; }
        int best = 0; float bs = 0.f;
#pragma unroll
        for (int g = 0; g < 4; ++g) { float m1 = sel[4 * g], m2 = -3.0e38f;
#pragma unroll
            for (int j = 1; j < 4; ++j) { const float t = sel[4 * g + j]; if (t > m1) { m2 = m1; m1 = t; } else if (t > m2) m2 = t; }
            const float gs = m1 + m2; if (g == 0 || gs > bs) { bs = gs; best = g; } }
        float s4[4], a4[4];
#pragma unroll
        for (int j = 0; j < 4; ++j) { s4[j] = best == 0 ? sel[j] : (best == 1 ? sel[4 + j] : (best == 2 ? sel[8 + j] : sel[12 + j])); a4[j] = best == 0 ? aff[j] : (best == 1 ? aff[4 + j] : (best == 2 ? aff[8 + j] : aff[12 + j])); }
        int i1 = 0; float v1 = s4[0];
#pragma unroll
        for (int j = 1; j < 4; ++j) if (s4[j] > v1) { v1 = s4[j]; i1 = j; }
        int i2 = -1; float v2 = 0.f;
#pragma unroll
        for (int j = 0; j < 4; ++j) if (j != i1 && (i2 < 0 || s4[j] > v2)) { v2 = s4[j]; i2 = j; }
        const int lo = i1 < i2 ? i1 : i2, hi = i1 < i2 ? i2 : i1;
        const float alo = lo == 0 ? a4[0] : (lo == 1 ? a4[1] : a4[2]), ahi = hi == 1 ? a4[1] : (hi == 2 ? a4[2] : a4[3]);
        const float inv = 1.0f / (alo + ahi);
        const int pidx = lo == 0 ? hi - 1 : (lo == 1 ? hi + 1 : 5);
        const int cls = best * 6 + pidx;
        SELC[tid] = cls; SELW[tid] = (f32x2){alo * inv, ahi * inv};
        atomicAdd((int*)&CNT[cls], 1);
    }
    __syncthreads();
    if (tid < NCLS) BASE[tid] = (int)__hip_atomic_fetch_add(X.ctl + cwc + tid, (unsigned)CNT[tid], __ATOMIC_RELAXED, __HIP_MEMORY_SCOPE_AGENT);
    __syncthreads();
    if (tid < nrows) { const int c = SELC[tid]; int rank = 0; for (int j = 0; j < tid; ++j) rank += (SELC[j] == c) ? 1 : 0;
        const int pos = BASE[c] + rank; X.list[(size_t)c * CAP + pos] = row0 + tid; X.wtl[(size_t)c * CAP + pos] = SELW[tid]; }
    __syncthreads();
}

constexpr int PH_PER_LAYER = 9, N_PHASES = 1 + DEPTH * PH_PER_LAYER;
__global__ void __launch_bounds__(512, 2) k_fwd(Args a) {
    extern __shared__ __attribute__((aligned(16))) unsigned char lds_raw[];
    Base X;
    X.lds = (LAS unsigned char*)lds_raw;
    X.tid = threadIdx.x; X.lane = X.tid & 63; X.wave = __builtin_amdgcn_readfirstlane(X.tid >> 6); X.bid = blockIdx.x; X.G = gridDim.x;
    for (int u = X.tid; u < (LDS_BYTES - LDS_MISC) / 4; u += 512) ((LAS unsigned*)(X.lds + LDS_MISC))[u] = 0u;
    __syncthreads();
#if MK_MULTI
#define GRID_BAR() do { } while (0)
#else
    XcdBarrier bar = xcd_barrier_post((unsigned*)(a.ws + WS_CTL) + CW_BAR, (volatile LAS unsigned*)(X.lds + MISC_BAR));
#define GRID_BAR() xcd_barrier(bar)
#endif
    const int lo = a.ph_lo, hi = a.ph_hi;
#define IN(k) (lo <= (k) && (k) < hi)
#define SEAM(k) do { if (IN((k) + 1)) GRID_BAR(); } while (0)
#define RUNPH(idx, k, call) do { if (PHM(idx) && IN(k)) { call; if (PROBE_REP == (idx)) { GRID_BAR(); call; } SEAM(k); } } while (0)
    RUNPH(0, 0, phase_p0(X));
    for (int l = 0; l < DEPTH; ++l) {
        const int pb = 1 + l * PH_PER_LAYER;
        if (PHM(1) && IN(pb + 0)) { if (phase_norm1(X, l)) gemm_phase<K_IN, true>(X, l, 1); SEAM(pb + 0); }
        RUNPH(2, pb + 1, (gemm_phase<K_IN, true>(X, l, 0)));
        RUNPH(3, pb + 2, phase_lru<false>(X, l));
        RUNPH(4, pb + 3, phase_attn(X, l));
        if (PHM(5) && IN(pb + 4)) {
            if (l < DEPTH - 1 && X.bid >= (int)gridDim.x - NCTX_OUT) { unsigned* ctl = (unsigned*)(a.ws + WS_CTL);
                wait_count(ctl + CW_ECTX + l * 64, 128u, ctl + CW_BAR + XB_TMO); gemm_phase<K_OUT, EPI_ALIGN_RMW>(X, l, 1); }
            else phase_lru2(X, l);
            SEAM(pb + 4); }
        RUNPH(6, pb + 5, (gemm_phase<K_OUT, EPI_ALIGN_RMW>(X, l, 0)));
        if (PHM(7) && IN(pb + 6)) { phase_router(X, l, 0); if (PROBE_REP == 7) { GRID_BAR(); phase_router(X, l, 1); } SEAM(pb + 6); }
        if (PHM(8) && IN(pb + 7)) { gemm_phase<K_UP, true>(X, l, 0); if (MK_MULTI || !IN(pb + 8)) { } }
        RUNPH(9, pb + 8, (gemm_phase<K_DOWN, EPI_ALIGN_RMW>(X, l, 0)));
    }
#undef RUNPH
#undef IN
#undef SEAM
}

extern "C" void kernel_launch(void* const* d_in, const int* in_sizes, int n_in, void* d_out, int out_size, void* d_ws, size_t ws_size, hipStream_t stream) {
    static int grid = 0;
    if (grid == 0) {
        if (n_in != 25 || out_size != RL * D || ws_size < WS_END) { fprintf(stderr, "kernel_launch: unexpected shapes (n_in %d out %d ws %zu)\n", n_in, out_size, ws_size); grid = -1; return; }
        int dev = 0, cus = 0, per_cu = 0;
        if (hipGetDevice(&dev) != hipSuccess || hipDeviceGetAttribute(&cus, hipDeviceAttributeMultiprocessorCount, dev) != hipSuccess) { grid = -1; return; }
        if (hipFuncSetAttribute((const void*)k_fwd, hipFuncAttributeMaxDynamicSharedMemorySize, LDS_BYTES) != hipSuccess) { fprintf(stderr, "kernel_launch: hipFuncSetAttribute failed\n"); grid = -1; return; }
        if (hipOccupancyMaxActiveBlocksPerMultiprocessor(&per_cu, (const void*)k_fwd, 512, LDS_BYTES) != hipSuccess || per_cu < 1) fprintf(stderr, "kernel_launch: occupancy query says %d\n", per_cu);
        (void)hipGetLastError();
        grid = cus < 256 ? cus : 256;
    }
    if (grid < 0) return;
    (void)hipMemsetAsync((char*)d_ws + WS_CTL, 0, CTL_BYTES, stream);
    Args a{};
    for (int i = 0; i < 25; ++i) a.in[i] = (const float*)d_in[i];
    a.out = (float*)d_out; a.ws = (unsigned char*)d_ws;
#if MK_MULTI
    for (int p = 0; p < N_PHASES; ++p) { a.ph_lo = p; a.ph_hi = p + 1; hipLaunchKernelGGL(k_fwd, dim3(grid), dim3(512), LDS_BYTES, stream, a); }
#else
    a.ph_lo = 0; a.ph_hi = N_PHASES;
    hipLaunchKernelGGL(k_fwd, dim3(grid), dim3(512), LDS_BYTES, stream, a);
#endif
}
```

```cpp
#include <hip/hip_runtime.h>
#include <cstdio>
#include <cstdint>

#ifndef PH_MASK
#define PH_MASK 0x3ff
#endif
#define PHM(i) ((PH_MASK >> (i)) & 1)
#ifndef EPI_ALIGN_RMW
#define EPI_ALIGN_RMW true
#endif
#ifndef PROBE_REP
#define PROBE_REP -1
#endif
#ifndef TPROF
#define TPROF -1
#endif
#ifndef TPROF_AMP
#define TPROF_AMP 2
#endif
#ifndef TPROF_MEAN
#define TPROF_MEAN 1
#endif
#ifndef MK_MULTI
#define MK_MULTI 0
#endif

#define LAS __attribute__((address_space(3)))
#define DI __device__ __forceinline__
typedef unsigned short bf16_t;
typedef short bf16x8 __attribute__((ext_vector_type(8)));
typedef short s16x4 __attribute__((ext_vector_type(4)));
typedef short v4i16_t __attribute__((ext_vector_type(4)));
typedef float f32x2 __attribute__((ext_vector_type(2)));
typedef float f32x4 __attribute__((ext_vector_type(4)));
typedef float f32x16 __attribute__((ext_vector_type(16)));
typedef unsigned u32x2 __attribute__((ext_vector_type(2)));
typedef unsigned u32x4 __attribute__((ext_vector_type(4)));
typedef __bf16 bf16x2_t __attribute__((ext_vector_type(2)));

constexpr int D = 1024, DEPTH = 4, SEQ = 8192, NB = 4, CTX = 256;
constexpr int RL = NB * SEQ;
constexpr int RC = NB * CTX;
constexpr int R = RL + RC;
constexpr int NIN = 2560;
constexpr int NCLS = 24, CAP = R + 256;
constexpr int NCHUNK = R / 64;
constexpr float EPS = 1e-6f;
constexpr float LOG2E = 1.4426950408889634f;
constexpr float QSCALE = 0.125f * LOG2E;
constexpr float NEGBIG = -1e30f;

constexpr size_t MiB = 1u << 20;
constexpr size_t WS_CTL = 0, CTL_BYTES = 131072;
constexpr size_t WS_MOD = 1 * MiB;
constexpr size_t WS_SP8 = 2 * MiB;
constexpr size_t WS_GATEW = 3 * MiB;
constexpr size_t WS_WIN = 4 * MiB;
constexpr size_t WS_WOUT = 24 * MiB;
constexpr size_t WS_WUP = 32 * MiB;
constexpr size_t WS_WDN = 160 * MiB;
constexpr size_t WS_HB = 224 * MiB;
constexpr size_t WS_QKV = 290 * MiB;
constexpr size_t QKV_STRIDE = 33 * MiB;
constexpr size_t WS_XC = 455 * MiB;
constexpr size_t WS_AGG = 459 * MiB;
constexpr size_t WS_CARRY = 464 * MiB;
constexpr size_t WS_LIST = 467 * MiB;
constexpr size_t WS_WTL = 471 * MiB;
constexpr size_t WS_XB = 480 * MiB;
constexpr size_t WS_END = 546 * MiB;
static_assert((size_t)R * 512 * 2 <= QKV_STRIDE && (size_t)(R + NCLS * 256) * 2048 <= 5 * QKV_STRIDE, "ws map");
static_assert((size_t)NCLS * CAP * 4 <= 4 * MiB && (size_t)NCLS * CAP * 8 <= 7 * MiB, "ws map lists");
constexpr int CW_BAR = 1024;
constexpr int CW_CLS = 8192;
constexpr int CW_PAN = 12288;
constexpr int CW_CONV = 15616;
constexpr int CW_CARRY = 14848;
constexpr int CW_CDONE = 16192;
constexpr int CW_ECTX = 14336;
constexpr int CW_DONE = 16384;
constexpr int NCTX_IN = 40, NCTX_OUT = 16;

constexpr int LDS_BYTES = 147456;
constexpr int LDS_MISC = 131072;
constexpr int MISC_BAR = LDS_MISC + 320;
constexpr int MISC_GATE = LDS_MISC + 4096;
constexpr int MISC_CONV = LDS_MISC + 3072;
constexpr int MISC_CLS = LDS_MISC + 1024;

DI unsigned pk2(float lo, float hi) { f32x2 v = {lo, hi}; bf16x2_t b = __builtin_convertvector(v, bf16x2_t); return __builtin_bit_cast(unsigned, b); }
DI float bflo(unsigned w) { return __uint_as_float(w << 16); }
DI float bfhi(unsigned w) { return __uint_as_float(w & 0xffff0000u); }
DI void unpack8(const u32x4 w, f32x4& a, f32x4& b) { a = (f32x4){bflo(w.x), bfhi(w.x), bflo(w.y), bfhi(w.y)}; b = (f32x4){bflo(w.z), bfhi(w.z), bflo(w.w), bfhi(w.w)}; }
DI u32x4 pack8(const f32x4 a, const f32x4 b) { u32x4 w; w.x = pk2(a.x, a.y); w.y = pk2(a.z, a.w); w.z = pk2(b.x, b.y); w.w = pk2(b.z, b.w); return w; }
DI float shflx(float v, int o, int lane) { return __int_as_float(__builtin_amdgcn_ds_bpermute((lane ^ o) << 2, __float_as_int(v))); }
DI float wave_sum(float v, int lane) {
#pragma unroll
    for (int o = 1; o < 64; o <<= 1) v += shflx(v, o, lane);
    return v;
}
DI float fexp2(float x) { return __builtin_amdgcn_exp2f(x); }
DI float frcp(float x) { return __builtin_amdgcn_rcpf(x); }
DI float sigmoidf_(float x) { return frcp(1.0f + fexp2(-LOG2E * x)); }
DI float gelu_tanh(float x) { const float u = 0.7978845608028654f * (x + 0.044715f * x * x * x); return x * frcp(1.0f + fexp2(-2.0f * LOG2E * u)); }
#define LDS_WAIT() asm volatile("s_waitcnt lgkmcnt(0)" ::: "memory")
DI void st_wt_b32(void* p, float v) { asm volatile("global_store_dword %0, %1, off sc1" :: "v"(p), "v"(v) : "memory"); }
DI void st_wt_b64(void* p, u32x2 v) { asm volatile("global_store_dwordx2 %0, %1, off sc1" :: "v"(p), "v"(v) : "memory"); }

#define XB_TMO      128
#define XB_XCNT(j)  (256  + 64 * (j))
#define XB_XSUB(j)  (1280 + 64 * (j))
#define XB_XGEN(j)  (2304 + 64 * (j))
#define XB_TOP      3328
#define XB_TOPGEN   3392
#define XCD_BAR_WORDS 3456
#define XB_SPIN_CAP (1u << 18)
DI unsigned xb_ld(unsigned* p)              { return __hip_atomic_load(p, __ATOMIC_RELAXED, __HIP_MEMORY_SCOPE_AGENT); }
DI unsigned xb_add(unsigned* p, unsigned v) { return __hip_atomic_fetch_add(p, v, __ATOMIC_RELAXED, __HIP_MEMORY_SCOPE_AGENT); }
DI unsigned xb_xcc_id() { return (unsigned)__builtin_amdgcn_s_getreg((3 << 11) | 20) & 0xFu; }
#define XB_SPIN(cond, bar) do { unsigned _sp = 0; while (cond) { __builtin_amdgcn_s_sleep(1); \
    if ((++_sp & 255u) == 0u) { if (xb_ld(&(bar)[XB_TMO])) break; if (_sp > XB_SPIN_CAP) { atomicAdd(&(bar)[XB_TMO], 1u); break; } } } } while (0)
struct XcdBarrier { unsigned* bar; unsigned x; volatile LAS unsigned* st; };
DI XcdBarrier xcd_barrier_post(unsigned* bar, volatile LAS unsigned* st) {
    XcdBarrier b; b.bar = bar; b.x = xb_xcc_id(); b.st = st;
    if (threadIdx.x == 0) (void)xb_add(&bar[XB_XCNT(b.x)], 1u);
    return b;
}
DI void xcd_barrier_complete(unsigned* bar, unsigned x, unsigned& nloc, unsigned& nx) {
    const unsigned G = gridDim.x * gridDim.y * gridDim.z;
    unsigned sum, cnt, mine, sp = 0u;
    for (;;) {
        sum = 0u; cnt = 0u; mine = 0u;
#pragma unroll
        for (unsigned j = 0; j < 16; ++j) { const unsigned c = xb_ld(&bar[XB_XCNT(j)]); sum += c; cnt += (c > 0u) ? 1u : 0u; mine = (j == x) ? c : mine; }
        if (sum == G) break;
        __builtin_amdgcn_s_sleep(1);
        if ((++sp & 255u) == 0u) { if (xb_ld(&bar[XB_TMO])) break; if (sp > XB_SPIN_CAP) { atomicAdd(&bar[XB_TMO], 1u); break; } }
    }
    nloc = mine > 0u ? mine : 1u; nx = cnt > 0u ? cnt : 1u;
}
DI void xcd_barrier(const XcdBarrier& b) {
    asm volatile("s_waitcnt vmcnt(0)" ::: "memory");
    __syncthreads();
    if (threadIdx.x == 0) {
        unsigned* bar = b.bar;
        __builtin_amdgcn_s_waitcnt(0);
        unsigned nloc = b.st[0], nx = b.st[1];
        if (nloc == 0u) { xcd_barrier_complete(bar, b.x, nloc, nx); b.st[0] = nloc; b.st[1] = nx; }
        const unsigned old = xb_add(&bar[XB_XSUB(b.x)], 1u);
        const unsigned gen = old / nloc;
        if (old + 1u == (gen + 1u) * nloc) {
            __builtin_amdgcn_fence(__ATOMIC_RELEASE, "agent");
            asm volatile("s_waitcnt vmcnt(0)" ::: "memory");
            const unsigned og = xb_add(&bar[XB_TOP], 1u);
            const unsigned tg = og / nx;
            if (og + 1u == (tg + 1u) * nx) xb_add(&bar[XB_TOPGEN], 1u);
            else XB_SPIN(xb_ld(&bar[XB_TOPGEN]) == tg, bar);
            __builtin_amdgcn_fence(__ATOMIC_ACQUIRE, "agent");
            xb_add(&bar[XB_XGEN(b.x)], 1u);
            asm volatile("s_waitcnt vmcnt(0)" ::: "memory");
        } else {
            XB_SPIN(xb_ld(&bar[XB_XGEN(b.x)]) == gen, bar);
            __builtin_amdgcn_fence(__ATOMIC_ACQUIRE, "agent");
            asm volatile("s_waitcnt vmcnt(0)" ::: "memory");
        }
    }
    __syncthreads();
}

DI void xcd_barrier_arrive(const XcdBarrier& b) {
    asm volatile("s_waitcnt vmcnt(0)" ::: "memory");
    __syncthreads();
    if (threadIdx.x == 0) {
        unsigned* bar = b.bar;
        __builtin_amdgcn_s_waitcnt(0);
        unsigned nloc = b.st[0], nx = b.st[1];
        if (nloc == 0u) { xcd_barrier_complete(bar, b.x, nloc, nx); b.st[0] = nloc; b.st[1] = nx; }
        const unsigned old = xb_add(&bar[XB_XSUB(b.x)], 1u);
        const unsigned gen = old / nloc;
        if (old + 1u == (gen + 1u) * nloc) {
            __builtin_amdgcn_fence(__ATOMIC_RELEASE, "agent");
            asm volatile("s_waitcnt vmcnt(0)" ::: "memory");
            const unsigned og = xb_add(&bar[XB_TOP], 1u);
            const unsigned tg = og / nx;
            if (og + 1u == (tg + 1u) * nx) xb_add(&bar[XB_TOPGEN], 1u);
            else XB_SPIN(xb_ld(&bar[XB_TOPGEN]) == tg, bar);
            __builtin_amdgcn_fence(__ATOMIC_ACQUIRE, "agent");
            xb_add(&bar[XB_XGEN(b.x)], 1u);
            asm volatile("s_waitcnt vmcnt(0)" ::: "memory");
            b.st[2] = 0xffffffffu;
        } else b.st[2] = gen;
    }
    __syncthreads();
}
DI void xcd_barrier_wait(const XcdBarrier& b) {
    asm volatile("s_waitcnt vmcnt(0)" ::: "memory");
    __syncthreads();
    if (threadIdx.x == 0) {
        unsigned* bar = b.bar;
        const unsigned gen = b.st[2];
        if (gen != 0xffffffffu) {
            XB_SPIN(xb_ld(&bar[XB_XGEN(b.x)]) == gen, bar);
            __builtin_amdgcn_fence(__ATOMIC_ACQUIRE, "agent");
            asm volatile("s_waitcnt vmcnt(0)" ::: "memory");
        }
    }
    __syncthreads();
}

DI void panel_sync(unsigned* cnt, unsigned expect, unsigned* tmo) {
    asm volatile("s_waitcnt vmcnt(0)" ::: "memory");
    __syncthreads();
    if (threadIdx.x == 0) {
        __builtin_amdgcn_fence(__ATOMIC_RELEASE, "agent");
        asm volatile("s_waitcnt vmcnt(0)" ::: "memory");
        (void)__hip_atomic_fetch_add(cnt, 1u, __ATOMIC_RELAXED, __HIP_MEMORY_SCOPE_AGENT);
        unsigned sp = 0;
        while (__hip_atomic_load(cnt, __ATOMIC_RELAXED, __HIP_MEMORY_SCOPE_AGENT) < expect) { __builtin_amdgcn_s_sleep(2); if (++sp > (1u << 22)) { atomicAdd(tmo, 1u); break; } }
        __builtin_amdgcn_fence(__ATOMIC_ACQUIRE, "agent");
        asm volatile("s_waitcnt vmcnt(0)" ::: "memory");
    }
    __syncthreads();
}

DI void wait_count(unsigned* cnt, unsigned expect, unsigned* tmo) {
    if (threadIdx.x == 0) {
        unsigned sp = 0;
        while (__hip_atomic_load(cnt, __ATOMIC_RELAXED, __HIP_MEMORY_SCOPE_AGENT) < expect) { __builtin_amdgcn_s_sleep(2); if (++sp > (1u << 22)) { atomicAdd(tmo, 1u); break; } }
        __builtin_amdgcn_fence(__ATOMIC_ACQUIRE, "agent");
        asm volatile("s_waitcnt vmcnt(0)" ::: "memory");
    }
    asm volatile("" ::: "memory"); __builtin_amdgcn_s_barrier(); asm volatile("" ::: "memory");
}

constexpr int MISC_TP = LDS_MISC + 2048, CW_TP = 16256;
DI unsigned tp_now() { return (unsigned)__builtin_amdgcn_s_memrealtime(); }
#define TP_BEGIN(id, var) unsigned var = 0u; if (TPROF == (id)) { if (threadIdx.x < 64) var = tp_now(); }
#define TP_END(id, var, L) do { if (TPROF == (id)) { if (threadIdx.x < 64) { const unsigned dt_ = tp_now() - var; if (threadIdx.x == 0) *(LAS unsigned*)((L) + MISC_TP) += dt_; } } } while (0)
struct Args { const float* in[25]; float* out; unsigned char* ws; int ph_lo, ph_hi; };
struct Base { LAS unsigned char* lds; int tid, lane, wave, bid, G; };
struct Ctx {
    LAS unsigned char* lds;
    int tid, lane, wave, bid, G;
    const float *x, *c, *ctx, *c_ctx, *w_mod, *b_mod, *norm_mix, *norm_ffn, *w_in, *w_out, *q_gain, *k_gain, *na_bias, *conv_w, *conv_b,
                *lru_w_r, *lru_b_r, *lru_w_i, *lru_b_i, *lru_lambda, *router_w, *router_b, *exp_w1, *exp_w3, *exp_w2;
    float* out;
    unsigned* ctl; float* mod; float* sp8; bf16_t* gatew; bf16_t* win; bf16_t* wout; bf16_t* wup; bf16_t* wdn;
    bf16_t* hb; bf16_t* qkv; bf16_t* hid; float* xc; f32x2* agg; float* carry; int* list; f32x2* wtl; bf16_t* xb;
};
typedef const __attribute__((address_space(4))) Args* KArgsP;
DI Ctx make_ctx(const Base& B) {
    auto kp = __builtin_amdgcn_kernarg_segment_ptr();
    asm volatile("" : "+s"(kp));
    KArgsP a = (KArgsP)kp;
    Ctx X;
    int tid_ = B.tid, bid_ = B.bid, g_ = B.G;
    asm volatile("" : "+v"(tid_)); asm volatile("" : "+s"(bid_), "+s"(g_));
    X.lds = B.lds; X.tid = tid_; X.lane = tid_ & 63; X.wave = __builtin_amdgcn_readfirstlane(tid_ >> 6); X.bid = bid_; X.G = g_;
    X.x = a->in[0]; X.c = a->in[1]; X.ctx = a->in[2]; X.c_ctx = a->in[3]; X.w_mod = a->in[4]; X.b_mod = a->in[5]; X.norm_mix = a->in[6]; X.norm_ffn = a->in[7];
    X.w_in = a->in[8]; X.w_out = a->in[9]; X.q_gain = a->in[10]; X.k_gain = a->in[11]; X.na_bias = a->in[12]; X.conv_w = a->in[13]; X.conv_b = a->in[14];
    X.lru_w_r = a->in[15]; X.lru_b_r = a->in[16]; X.lru_w_i = a->in[17]; X.lru_b_i = a->in[18]; X.lru_lambda = a->in[19]; X.router_w = a->in[20]; X.router_b = a->in[21];
    X.exp_w1 = a->in[22]; X.exp_w3 = a->in[23]; X.exp_w2 = a->in[24]; X.out = a->out;
    unsigned char* ws = a->ws;
    X.ctl = (unsigned*)(ws + WS_CTL); X.mod = (float*)(ws + WS_MOD); X.sp8 = (float*)(ws + WS_SP8); X.gatew = (bf16_t*)(ws + WS_GATEW);
    X.win = (bf16_t*)(ws + WS_WIN); X.wout = (bf16_t*)(ws + WS_WOUT); X.wup = (bf16_t*)(ws + WS_WUP); X.wdn = (bf16_t*)(ws + WS_WDN);
    X.hb = (bf16_t*)(ws + WS_HB); X.qkv = (bf16_t*)(ws + WS_QKV); X.hid = (bf16_t*)(ws + WS_QKV); X.xc = (float*)(ws + WS_XC);
    X.agg = (f32x2*)(ws + WS_AGG); X.carry = (float*)(ws + WS_CARRY); X.list = (int*)(ws + WS_LIST); X.wtl = (f32x2*)(ws + WS_WTL); X.xb = (bf16_t*)(ws + WS_XB);
    return X;
}
typedef _Float16 h16x2 __attribute__((ext_vector_type(2)));
DI u32x2* ab_ptr(const Ctx& X, int row, int dir) { return row < RL ? (u32x2*)X.out + ((size_t)(row >> 1) * 2 + dir) * 512 : (u32x2*)X.xc + ((size_t)((row - RL) >> 1) * 2 + dir) * 512; }
DI int row_mb(int row) { return row < RL ? (row >> 13) : 4; }

DI void p0_transpose_item(const float* W, int K, int N, bf16_t* WT, LAS float* scr, int kb, int nb, int lane) {
    const int k0 = 64 * kb, n0 = 64 * nb, n4 = 4 * (lane & 15), kq = lane >> 4;
    f32x4 v[16];
#pragma unroll
    for (int i = 0; i < 16; ++i) v[i] = *(const f32x4*)(W + (size_t)(k0 + 4 * i + kq) * N + n0 + n4);
#pragma unroll
    for (int i = 0; i < 16; ++i) { const int k = 4 * i + kq; *(LAS f32x4*)(scr + k * 64 + (n4 ^ (((k >> 3) & 7) << 2))) = v[i]; }
    LDS_WAIT(); asm volatile("" ::: "memory");
    const int kc = lane & 7, nl = lane >> 3;
#pragma unroll
    for (int j = 0; j < 8; ++j) { const int n = nl + 8 * j; const LAS float* sp = scr + (8 * kc) * 64 + (n ^ (kc << 2));
        u32x4 o; o.x = pk2(sp[0 * 64], sp[1 * 64]); o.y = pk2(sp[2 * 64], sp[3 * 64]); o.z = pk2(sp[4 * 64], sp[5 * 64]); o.w = pk2(sp[6 * 64], sp[7 * 64]);
        *(u32x4*)(WT + (size_t)(n0 + n) * K + k0 + 8 * kc) = o; }
    LDS_WAIT(); asm volatile("" ::: "memory");
}
constexpr int L_ITEMS = 640 + 256 + 4096 + 2048;
DI void conv_item(const Ctx& X, int l, int r, LAS float* scr, int lane) {
    const float* W; bf16_t* WT; int K, N, kb, nb;
    if (r < 640) { W = X.w_in + (size_t)l * 1024 * NIN; K = 1024; N = NIN; WT = X.win + (size_t)l * NIN * 1024; kb = r / 40; nb = r % 40; }
    else if ((r -= 640) < 256) { W = X.w_out + (size_t)l * 1024 * 1024; K = 1024; N = 1024; WT = X.wout + (size_t)l * 1024 * 1024; kb = r / 16; nb = r % 16; }
    else if ((r -= 256) < 4096) { const int e = r >> 8; int q = r & 255; const int which = q >> 7; q &= 127;
        W = (which ? X.exp_w3 : X.exp_w1) + (size_t)(l * 16 + e) * 1024 * 512; K = 1024; N = 512; WT = X.wup + ((size_t)(l * 16 + e) * 1024 + which * 512) * 1024; kb = q / 8; nb = q % 8; }
    else { r -= 4096; const int e = r >> 7, q = r & 127; W = X.exp_w2 + (size_t)(l * 16 + e) * 512 * 1024; K = 512; N = 1024; WT = X.wdn + (size_t)(l * 16 + e) * 1024 * 512; kb = q / 16; nb = q % 16; }
    p0_transpose_item(W, K, N, WT, scr, kb, nb, lane);
}
DI void phase_p0(const Base& B) {
    const Ctx X = make_ctx(B);
    LAS float* silu_c = (LAS float*)(X.lds);
    LAS float* red = (LAS float*)(X.lds + 32768);
    { float cvv[10];
#pragma unroll
      for (int q = 0; q < 10; ++q) { const int i = X.tid + 512 * q, v = i >> 10, k = i & 1023; const float* p = v < 4 ? X.c + v * 1024 + k : X.c_ctx + k; cvv[q] = *p; }
#pragma unroll
      for (int q = 0; q < 10; ++q) silu_c[X.tid + 512 * q] = cvv[q] * frcp(1.0f + fexp2(-LOG2E * cvv[q])); }
    __syncthreads();
    for (int u = X.bid; u < DEPTH * 192; u += X.G) {
        const int l = u / 192, n0 = (u % 192) * 32, kg = X.tid >> 3, cq = X.tid & 7;
        f32x4 acc[5];
#pragma unroll
        for (int v = 0; v < 5; ++v) acc[v] = (f32x4){0.f, 0.f, 0.f, 0.f};
        const float* wp = X.w_mod + ((size_t)l * 1024 + kg * 16) * 6144 + n0 + 4 * cq;
#pragma unroll 8
        for (int k = 0; k < 16; ++k) { const f32x4 w = *(const f32x4*)(wp + (size_t)k * 6144);
#pragma unroll
            for (int v = 0; v < 5; ++v) acc[v] += w * silu_c[v * 1024 + kg * 16 + k]; }
#pragma unroll
        for (int v = 0; v < 5; ++v) *(LAS f32x4*)(red + (kg * 5 + v) * 32 + 4 * cq) = acc[v];
        __syncthreads();
        if (X.tid < 160) { const int v = X.tid >> 5, col = X.tid & 31; float s = X.b_mod[l * 6144 + n0 + col];
#pragma unroll 8
            for (int g = 0; g < 64; ++g) s += red[(g * 5 + v) * 32 + col];
            X.mod[(size_t)(l * 5 + v) * 6144 + n0 + col] = s; }
        __syncthreads();
    }
    for (int i = X.bid * 512 + X.tid; i < DEPTH * 2 * 512; i += X.G * 512) X.sp8[i] = 8.0f * log1pf(__expf(-X.lru_lambda[i]));
    __syncthreads();
    LAS float* scr = (LAS float*)(X.lds + X.wave * 16384);
    const int gw = X.bid * 8 + X.wave, NGW = X.G * 8;
    for (int it = gw; it < L_ITEMS + 128; it += NGW) {
        if (it < L_ITEMS) conv_item(X, 0, it, scr, X.lane);
        else { const int mi = it - L_ITEMS; const int gate = (mi >> 3) & 1, ld = mi >> 4, blk = mi & 7;
            p0_transpose_item((gate ? X.lru_w_i : X.lru_w_r) + (size_t)(ld * 8 + blk) * 4096, 64, 64, X.gatew + (size_t)mi * 4096, scr, 0, 0, X.lane); }
    }
}
DI void phase_conv(const Base& B, int l) {
    const Ctx X = make_ctx(B);
    LAS float* scr = (LAS float*)(X.lds + X.wave * 16384);
    LAS int* slot = (LAS int*)(X.lds + MISC_CONV);
    const int x = X.bid & 7;
    unsigned* head = X.ctl + CW_CONV + (l * 8 + x) * 16;
    constexpr int NSH = L_ITEMS / 8, WCH = 8, NCH = NSH / WCH;
    static_assert(L_ITEMS % 8 == 0 && NSH % WCH == 0, "chunking");
    if (X.tid == 0) slot[0] = (int)__hip_atomic_fetch_add(head, 1u, __ATOMIC_RELAXED, __HIP_MEMORY_SCOPE_AGENT);
    __syncthreads();
    int c = slot[0], par = 0;
    while (c < NCH) {
        int nv = 0;
        if (X.tid == 0) nv = (int)__hip_atomic_fetch_add(head, 1u, __ATOMIC_RELAXED, __HIP_MEMORY_SCOPE_AGENT);
        conv_item(X, l, x * NSH + c * WCH + X.wave, scr, X.lane);
        if (X.tid == 0) slot[par ^ 1] = nv;
        __syncthreads();
        par ^= 1; c = slot[par];
    }
    __syncthreads();
}

template <bool BF> DI void norm1_rows(const Ctx& X, int l, int r0, int r1, int rs) {
    const int lane = X.lane;
#define CIX(j) (BF ? 8 * lane + 512 * ((j) >> 1) + 4 * ((j) & 1) : 4 * lane + 256 * (j))
#define XROWF(row) ((row) < RL ? X.x + (size_t)(row) * D : X.ctx + (size_t)((row) - RL) * D)
    f32x4 gn4[4], sc4[4], sh4[4], nv[4]; u32x4 nw[2]; int cmb = -1;
#pragma unroll
    for (int j = 0; j < 4; ++j) gn4[j] = *(const f32x4*)(X.norm_mix + l * D + CIX(j));
    if (r0 < r1) {
        if (BF) { nw[0] = *(const u32x4*)(X.xb + (size_t)r0 * D + 8 * lane); nw[1] = *(const u32x4*)(X.xb + (size_t)r0 * D + 512 + 8 * lane); }
        else {
#pragma unroll
            for (int j = 0; j < 4; ++j) nv[j] = *(const f32x4*)(XROWF(r0) + CIX(j)); } }
    for (int row = r0; row < r1; row += rs) {
        f32x4 v[4];
        if (BF) { unpack8(nw[0], v[0], v[1]); unpack8(nw[1], v[2], v[3]); }
        else {
#pragma unroll
            for (int j = 0; j < 4; ++j) v[j] = nv[j]; }
        if (row + rs < r1) {
            if (BF) { nw[0] = *(const u32x4*)(X.xb + (size_t)(row + rs) * D + 8 * lane); nw[1] = *(const u32x4*)(X.xb + (size_t)(row + rs) * D + 512 + 8 * lane); }
            else {
#pragma unroll
                for (int j = 0; j < 4; ++j) nv[j] = *(const f32x4*)(XROWF(row + rs) + CIX(j)); } }
        const int mb = row_mb(row);
        if (mb != cmb) { cmb = mb; const float* sh = X.mod + (size_t)((l * 5 + mb) * 6 + 0) * 1024;
#pragma unroll
            for (int j = 0; j < 4; ++j) { sh4[j] = *(const f32x4*)(sh + CIX(j)); sc4[j] = *(const f32x4*)(sh + 1024 + CIX(j)) + 1.0f; } }
        float s = 0.f;
#pragma unroll
        for (int j = 0; j < 4; ++j) s += (v[j].x * v[j].x + v[j].y * v[j].y) + (v[j].z * v[j].z + v[j].w * v[j].w);
        const float rsd = __builtin_amdgcn_rsqf(wave_sum(s, lane) * (1.0f / D) + EPS);
        bf16_t* o = X.hb + (size_t)row * D;
#pragma unroll
        for (int j = 0; j < 4; ++j) { const f32x4 y = v[j] * rsd * gn4[j] * sc4[j] + sh4[j];
            u32x2 w; w.x = pk2(y.x, y.y); w.y = pk2(y.z, y.w); *(u32x2*)(o + CIX(j)) = w; }
    }
#undef CIX
#undef XROWF
}
DI bool phase_norm1(const Base& B, int l) {
    const Ctx X = make_ctx(B);
    const int nlat = X.G - NCTX_IN;
    const bool isctx = X.bid >= nlat;
    const int j = X.bid - nlat, p = j / 10, q = j % 10;
    const int r0 = isctx ? RL + 256 * p + 26 * q + X.wave : X.bid * 8 + X.wave;
    const int r1 = isctx ? (q == 9 ? RL + 256 * p + 256 : RL + 256 * p + 26 * q + 26) : RL;
    if (l == 0) norm1_rows<false>(X, l, r0, r1, isctx ? 8 : nlat * 8); else norm1_rows<true>(X, l, r0, r1, isctx ? 8 : nlat * 8);
    if (isctx) panel_sync(X.ctl + CW_PAN + (l * 4 + p) * 64, 10u, X.ctl + CW_BAR + XB_TMO);
    return isctx;
}

constexpr int BK = 64, HALF = 128, HTB = HALF * BK * 2;
DI int lds_byte(int r, int c) { return r * 128 + ((((c >> 3) ^ r) & 7) << 4) + (c & 7) * 2; }
DI void stage_rc(int b, int& Rr, int& Cc) { Rr = b >> 7; Cc = ((((b >> 4) ^ Rr) & 7)) * 8; }
DI int perm32(int rho) { const int n = rho >> 4, i = rho & 15; return 8 * (i >> 2) + 4 * n + (i & 3); }

enum { K_IN = 0, K_OUT = 1, K_UP = 2, K_DOWN = 3 };
struct GU { const char* a; const char* b; const char* bh; int i0, i1, i2, i3; };
template <int KIND> struct GK {
    static constexpr size_t A_HSTEP = KIND == K_UP ? 0 : (size_t)128 * 2048;
    static constexpr size_t B_HSTEP = KIND == K_IN ? (size_t)32 * 2048 : (KIND == K_OUT ? (size_t)128 * 2048 : (KIND == K_UP ? (size_t)512 * 2048 : (size_t)128 * 1024));
    static constexpr int KS = KIND == K_DOWN ? 8 : 16;
};

DI void cls_tables(const Ctx& X, int l) {
    LAS int* ct = (LAS int*)(X.lds + MISC_CLS);
    if (X.tid < NCLS) ct[X.tid] = (int)__hip_atomic_load(X.ctl + CW_CLS + l * 32 + X.tid, __ATOMIC_RELAXED, __HIP_MEMORY_SCOPE_AGENT);
    __syncthreads();
    if (X.tid == 0) { int tb = 0;
        for (int c = 0; c < NCLS; ++c) { ct[32 + c] = tb; tb += (ct[c] + 255) >> 8; }
        ct[32 + NCLS] = tb; }
    __syncthreads();
    if (X.tid < 160) { int c = 0; while (c < NCLS - 1 && X.tid >= ct[32 + c + 1]) ++c; ct[64 + X.tid] = c; }
    __syncthreads();
}
DI int cls_of_tile(const LAS int* ct, int T) { return ct[64 + (T < 160 ? T : 159)]; }
DI void cls_experts(int c, int& elo, int& ehi) { const int g = c / 6, p = c % 6; const int lo = p < 3 ? 0 : (p < 5 ? 1 : 2); const int hi = p < 3 ? p + 1 : (p < 5 ? p - 1 : 3); elo = 4 * g + lo; ehi = 4 * g + hi; }

template <int KIND> DI bool gemm_unit(const Ctx& X, int l, int idx, GU& u, int mode) {
    const bool xo = (X.G == 256);
    const int x = X.bid & 7, j = idx * 32 + (X.bid >> 3);
    int un = idx * X.G + X.bid;
    if (KIND == K_IN) {
        int pm, pn;
        if (mode) { if (idx > 0) return false; un = (RL / 256) * 10 + X.bid - (X.G - NCTX_IN); pm = un / 10; pn = un % 10; }
        else if (xo) { if (j >= 160) return false;
            if (j < 128) { const int g = j >> 5, jj = j & 31; pm = 16 * x + 8 * (g & 1) + (jj >> 2); pn = 4 * (g >> 1) + (jj & 3); }
            else { const int jj = j - 128; pm = 16 * x + (jj >> 1); pn = 8 + (jj & 1); } }
        else { if (un >= (RL / 256) * 10) return false; pm = un / 10; pn = un % 10; }
        u.a = (const char*)X.hb + (size_t)pm * 256 * 2048;
        u.b = (const char*)X.win + ((size_t)l * NIN + 256 * pn) * 2048; u.bh = u.b;
        u.i0 = pm; u.i1 = pn; u.i2 = 0; u.i3 = 0; return true;
    } else if (KIND == K_OUT) {
        int pm, pn;
        if (mode) { if (idx > 0) return false; un = (RL / 256) * 4 + X.bid - (X.G - NCTX_OUT); pm = un / 4; pn = un % 4; }
        else if (xo) { if (j >= 64) return false; pm = 16 * x + 8 * (j >> 5) + ((j & 31) >> 2); pn = j & 3; }
        else { if (un >= (RL / 256) * 4) return false; pm = un / 4; pn = un % 4; }
        u.a = (const char*)X.hb + (size_t)pm * 256 * 2048;
        u.b = (const char*)X.wout + ((size_t)l * 1024 + 256 * pn) * 2048; u.bh = u.b;
        u.i0 = pm; u.i1 = pn; u.i2 = 0; u.i3 = 0; return true;
    } else if (KIND == K_UP) {
        const LAS int* ct = (const LAS int*)(X.lds + MISC_CLS);
        const int NT = ct[32 + NCLS];
        int T, pn;
        if (xo) { if (j >= NT) return false; const int g = x * NT + j; T = g >> 3; pn = g & 7; }
        else { if (un >= NT * 8) return false; T = un >> 3; pn = un & 7; }
        const int c = cls_of_tile(ct, T); int elo, ehi; cls_experts(c, elo, ehi);
        const int e = pn < 4 ? elo : ehi, pnl = pn & 3;
        u.a = (const char*)X.hb;
        u.b = (const char*)X.wup + ((size_t)(l * 16 + e) * 1024 + 128 * pnl) * 2048; u.bh = u.b;
        u.i0 = T; u.i1 = pn; u.i2 = c; u.i3 = (T - ct[32 + c]) * 256; return true;
    } else {
        const LAS int* ct = (const LAS int*)(X.lds + MISC_CLS);
        const int NT = ct[32 + NCLS];
        int T, pn;
        if (xo) { const int d0 = (x * NT) >> 1, nd = (((x + 1) * NT) >> 1) - d0, jr = idx * 32 + 31 - (X.bid >> 3);
            if (jr >= nd) return false;
            int loc = jr + 4; if (loc >= nd) loc -= nd;
            const int g = d0 + loc; T = g >> 2; pn = g & 3; }
        else { if (un >= NT * 4) return false; T = un >> 2; pn = un & 3; }
        const int c = cls_of_tile(ct, T); int elo, ehi; cls_experts(c, elo, ehi);
        u.a = (const char*)X.hid + (size_t)T * 256 * 2048;
        u.b = (const char*)X.wdn + ((size_t)(l * 16 + elo) * 1024 + 256 * pn) * 1024;
        u.bh = (const char*)X.wdn + ((size_t)(l * 16 + ehi) * 1024 + 256 * pn) * 1024 - 8 * 128;
        u.i0 = T; u.i1 = pn; u.i2 = c; u.i3 = (T - ct[32 + c]) * 256; return true;
    }
}
DI void gather_voffA(const Ctx& X, const GU& u, const int (&Rr)[2], const int (&Cc)[2], unsigned (&vo)[2][2]) {
    const LAS int* ct = (const LAS int*)(X.lds + MISC_CLS);
    const int cnt = ct[u.i2];
    int tk[2][2];
#pragma unroll
    for (int h = 0; h < 2; ++h)
#pragma unroll
        for (int i = 0; i < 2; ++i) { const int pos = u.i3 + 128 * h + Rr[i]; tk[h][i] = X.list[(size_t)u.i2 * CAP + (pos < cnt ? pos : 0)]; }
#pragma unroll
    for (int h = 0; h < 2; ++h)
#pragma unroll
        for (int i = 0; i < 2; ++i) { const int pos = u.i3 + 128 * h + Rr[i]; const int tok = pos < cnt ? tk[h][i] : 0; vo[h][i] = (unsigned)(tok * 1024 + Cc[i]) * 2u; }
}

template <int KIND> DI void gemm_epilogue(const Ctx& X, int l, const f32x4 (&acc)[2][2][4][2], const GU& u, int wr, int wc, int fr, int fq, int par) {
    if (KIND == K_IN) {
        const int pm = u.i0, pn = u.i1, buf = pn >> 1;
        bf16_t* O = X.qkv + (size_t)buf * (QKV_STRIDE / 2);
        const int colb = 256 * (pn & 1) + 64 * wc + 8 * fq;
        if (buf < 2) {
            const float* gp = (buf == 0 ? X.q_gain : X.k_gain) + l * 64; const float scl = buf == 0 ? QSCALE : 1.0f;
            f32x4 gv[2][2];
#pragma unroll
            for (int bj = 0; bj < 2; ++bj)
#pragma unroll
                for (int n = 0; n < 2; ++n) gv[bj][n] = *(const f32x4*)(gp + 32 * bj + 8 * fq + 4 * n) * scl;
#pragma unroll
            for (int ai = 0; ai < 2; ++ai)
#pragma unroll
                for (int m = 0; m < 4; ++m) {
                    float ss = 0.f;
#pragma unroll
                    for (int bj = 0; bj < 2; ++bj)
#pragma unroll
                        for (int n = 0; n < 2; ++n) { const f32x4 v = acc[ai][bj][m][n]; ss += (v.x * v.x + v.y * v.y) + (v.z * v.z + v.w * v.w); }
                    ss += shflx(ss, 16, X.lane); ss += shflx(ss, 32, X.lane);
                    const float rs = __builtin_amdgcn_rsqf(ss * (1.0f / 64.0f) + EPS);
                    bf16_t* rowp = O + (size_t)(pm * 256 + ai * 128 + wr * 64 + m * 16 + fr) * 512 + colb;
#pragma unroll
                    for (int bj = 0; bj < 2; ++bj) { const f32x4 v0 = acc[ai][bj][m][0] * gv[bj][0] * rs, v1 = acc[ai][bj][m][1] * gv[bj][1] * rs;
                        u32x4 w; w.x = pk2(v0.x, v0.y); w.y = pk2(v0.z, v0.w); w.z = pk2(v1.x, v1.y); w.w = pk2(v1.z, v1.w); *(u32x4*)(rowp + 32 * bj) = w; }
                }
        } else {
#pragma unroll
            for (int ai = 0; ai < 2; ++ai)
#pragma unroll
                for (int m = 0; m < 4; ++m) {
                    bf16_t* rowp = O + (size_t)(pm * 256 + ai * 128 + wr * 64 + m * 16 + fr) * 512 + colb;
#pragma unroll
                    for (int bj = 0; bj < 2; ++bj) { const f32x4 v0 = acc[ai][bj][m][0], v1 = acc[ai][bj][m][1];
                        u32x4 w; w.x = pk2(v0.x, v0.y); w.y = pk2(v0.z, v0.w); w.z = pk2(v1.x, v1.y); w.w = pk2(v1.z, v1.w); *(u32x4*)(rowp + 32 * bj) = w; }
                }
        }
    } else if (KIND == K_OUT) {
        const int pm = u.i0, pn = u.i1, row0 = pm * 256;
        const float* xin = row0 < RL ? X.x + (size_t)row0 * D : X.ctx + (size_t)(row0 - RL) * D;
        bf16_t* xo = X.xb + (size_t)row0 * D;
        const __amdgpu_buffer_rsrc_t xrs = __builtin_amdgcn_make_buffer_rsrc((void*)X.xb, 0, (int)((size_t)R * 2048), 0x00020000);
        const int col0 = 256 * pn + 32 * wc + 8 * fq;
        const LAS float* gl = (const LAS float*)(X.lds + MISC_GATE + par * 1024) + 32 * wc + 8 * fq;
#define G_GV(bj, n) (*(const LAS f32x4*)(gl + 128 * (bj) + 4 * (n)))
        if (l == 0) {
#pragma unroll
            for (int ai = 0; ai < 2; ++ai)
#pragma unroll
                for (int m = 0; m < 4; ++m) { const size_t ro = (size_t)(ai * 128 + wr * 64 + m * 16 + fr) * D + col0;
                    const f32x4 xa0 = *(const f32x4*)(xin + ro), xa1 = *(const f32x4*)(xin + ro + 4), xb0 = *(const f32x4*)(xin + ro + 128), xb1 = *(const f32x4*)(xin + ro + 132);
                    *(u32x4*)(xo + ro) = pack8(xa0 + G_GV(0, 0) * acc[ai][0][m][0], xa1 + G_GV(0, 1) * acc[ai][0][m][1]);
                    *(u32x4*)(xo + ro + 128) = pack8(xb0 + G_GV(1, 0) * acc[ai][1][m][0], xb1 + G_GV(1, 1) * acc[ai][1][m][1]); }
        } else {
#pragma unroll
            for (int ai = 0; ai < 2; ++ai) { u32x4 ob[4][2];
#pragma unroll
                for (int m = 0; m < 4; ++m)
#pragma unroll
                    for (int bj = 0; bj < 2; ++bj) ob[m][bj] = __builtin_amdgcn_raw_buffer_load_b128(xrs, (int)(((size_t)(row0 + ai * 128 + wr * 64 + m * 16 + fr) * D + col0 + 128 * bj) * 2), 0, 0);
                asm volatile("" ::: "memory");
#pragma unroll
                for (int m = 0; m < 4; ++m)
#pragma unroll
                    for (int bj = 0; bj < 2; ++bj) { f32x4 x0, x1; unpack8(ob[m][bj], x0, x1);
                        __builtin_amdgcn_raw_buffer_store_b128(pack8(x0 + G_GV(bj, 0) * acc[ai][bj][m][0], x1 + G_GV(bj, 1) * acc[ai][bj][m][1]), xrs, (int)(((size_t)(row0 + ai * 128 + wr * 64 + m * 16 + fr) * D + col0 + 128 * bj) * 2), 0, 0); } }
        }
#undef G_GV
    } else if (KIND == K_UP) {
        const int T = u.i0, pn = u.i1, c = u.i2, pos0 = u.i3, which = pn >> 2, pnl = pn & 3;
        const int col0 = 512 * which + 128 * pnl + 32 * wc + 8 * fq;
        const __amdgpu_buffer_rsrc_t hrs = __builtin_amdgcn_make_buffer_rsrc((void*)X.hid, 0, (int)((size_t)(R + NCLS * 256) * 2048), 0x00020000);
        float w2a[2][4];
        { const LAS float* wl = (const LAS float*)(X.lds + MISC_GATE + par * 1024);
#pragma unroll
          for (int ai = 0; ai < 2; ++ai)
#pragma unroll
              for (int m = 0; m < 4; ++m) w2a[ai][m] = wl[ai * 128 + wr * 64 + m * 16 + fr]; }
#pragma unroll
        for (int ai = 0; ai < 2; ++ai)
#pragma unroll
            for (int m = 0; m < 4; ++m) { const int lr = ai * 128 + wr * 64 + m * 16 + fr;
                const float wt = w2a[ai][m];
                float o[8];
#pragma unroll
                for (int n = 0; n < 2; ++n)
#pragma unroll
                    for (int e = 0; e < 4; ++e) { const float a = acc[ai][0][m][n][e], b = acc[ai][1][m][n][e]; o[4 * n + e] = a * frcp(1.0f + fexp2(-LOG2E * a)) * b * wt; }
                u32x4 w; w.x = pk2(o[0], o[1]); w.y = pk2(o[2], o[3]); w.z = pk2(o[4], o[5]); w.w = pk2(o[6], o[7]);
                __builtin_amdgcn_raw_buffer_store_b128(w, hrs, (int)(((size_t)(T * 256 + lr) * 1024 + col0) * 2), 0, 16); }
    } else {
        const int pn = u.i1, c = u.i2, pos0 = u.i3;
        const LAS int* ct = (const LAS int*)(X.lds + MISC_CLS); const int cnt = ct[c];
        const int col0 = 256 * pn + 32 * wc + 8 * fq;
        const LAS unsigned char* gt = X.lds + MISC_GATE + 2048 + par * 5120 + (32 * wc + 8 * fq) * 4;
        int tok[2][4];
#pragma unroll
        for (int ai = 0; ai < 2; ++ai)
#pragma unroll
            for (int m = 0; m < 4; ++m) { const int pos = pos0 + ai * 128 + wr * 64 + m * 16 + fr; tok[ai][m] = pos < cnt ? X.list[(size_t)c * CAP + pos] : -1; }
#pragma unroll
        for (int ai = 0; ai < 2; ++ai) { u32x4 ob[4][2];
#pragma unroll
            for (int m = 0; m < 4; ++m) { const int tk = tok[ai][m] < 0 ? 0 : tok[ai][m]; const bf16_t* xi = X.xb + (size_t)tk * D + col0;
#pragma unroll
                for (int bj = 0; bj < 2; ++bj) ob[m][bj] = *(const u32x4*)(xi + 128 * bj); }
            asm volatile("" ::: "memory");
#pragma unroll
            for (int m = 0; m < 4; ++m) { const int tk = tok[ai][m];
                if (tk >= 0) { const LAS unsigned char* gm_ = gt + row_mb(tk) * 1024;
#pragma unroll
                    for (int bj = 0; bj < 2; ++bj) { f32x4 x0, x1; unpack8(ob[m][bj], x0, x1);
                        x0 += *(const LAS f32x4*)(gm_ + 512 * bj) * acc[ai][bj][m][0]; x1 += *(const LAS f32x4*)(gm_ + 512 * bj + 16) * acc[ai][bj][m][1];
                        if (l == DEPTH - 1) { float* of = X.out + (size_t)tk * D + col0 + 128 * bj; *(f32x4*)of = x0; *(f32x4*)(of + 4) = x1; }
                        else *(u32x4*)(X.xb + (size_t)tk * D + col0 + 128 * bj) = pack8(x0, x1); } } } }
    }
}

template <int KIND, bool ALIGN_EPI> DI void gemm_phase(const Base& B, int l, int mode) {
    const Ctx X = make_ctx(B);
    if (KIND == K_UP || KIND == K_DOWN) cls_tables(X, l);
    LAS unsigned char* lds = X.lds;
    const int tid = X.tid, wid = X.wave, lane = X.lane, wr = wid >> 2, wc = wid & 3, fr = lane & 15, fq = lane >> 4;
    constexpr int nt = 16, KS = GK<KIND>::KS;
    constexpr size_t kstep = 128, ahstep = GK<KIND>::A_HSTEP, bhstep = GK<KIND>::B_HSTEP;
    int Rr[2], Cc[2]; unsigned voffB[2], voc[2][2], von[2][2];
#pragma unroll
    for (int i = 0; i < 2; ++i) { stage_rc(tid * 16 + i * 8192, Rr[i], Cc[i]);
        if (KIND == K_IN) voffB[i] = (unsigned)((64 * (Rr[i] >> 5) + perm32(Rr[i] & 31)) * 1024 + Cc[i]) * 2u;
        else if (KIND == K_DOWN) voffB[i] = (unsigned)(((Rr[i] & ~31) + perm32(Rr[i] & 31)) * 512 + Cc[i]) * 2u;
        else voffB[i] = (unsigned)(((Rr[i] & ~31) + perm32(Rr[i] & 31)) * 1024 + Cc[i]) * 2u;
        voc[0][i] = voc[1][i] = von[0][i] = von[1][i] = (unsigned)(Rr[i] * 1024 + Cc[i]) * 2u; }
    const unsigned ldsw = (unsigned)wid * 1024u;
    const int aoff = lds_byte(wr * 64 + fr, fq * 8), boff = lds_byte(wc * 32 + fr, fq * 8), aoff1 = lds_byte(wr * 64 + fr, 32 + fq * 8), boff1 = lds_byte(wc * 32 + fr, 32 + fq * 8);
#define G_SA(b, h) (((b) * 2 + (h)) * HTB)
#define G_SB(b, h) ((4 + (b) * 2 + (h)) * HTB)
#define G_STAGE(bufoff, gbase, v0, v1) do { \
        __builtin_amdgcn_global_load_lds((const unsigned*)((const char*)(gbase) + (v0)), (LAS unsigned*)(lds + (bufoff) + ldsw), 16, 0, 0); \
        __builtin_amdgcn_global_load_lds((const unsigned*)((const char*)(gbase) + (v1)), (LAS unsigned*)(lds + (bufoff) + ldsw + 8192), 16, 0, 0); } while (0)
#define G_STAGE_B(bufoff, gbase) G_STAGE(bufoff, gbase, voffB[0], voffB[1])
#define G_LDA(dst, b, h) do { _Pragma("unroll") for (int m = 0; m < 4; ++m) _Pragma("unroll") for (int k = 0; k < 2; ++k) dst[m][k] = *(const LAS bf16x8*)(lds + G_SA(b, h) + (k ? aoff1 : aoff) + m * 2048); } while (0)
#define G_LDB(dst, b, h) do { _Pragma("unroll") for (int n = 0; n < 2; ++n) _Pragma("unroll") for (int k = 0; k < 2; ++k) dst[n][k] = *(const LAS bf16x8*)(lds + G_SB(b, h) + (k ? boff1 : boff) + n * 2048); } while (0)
#define G_MMA(ai, bj, At, Bt) do { __builtin_amdgcn_s_setprio(1); _Pragma("unroll") for (int m = 0; m < 4; ++m) _Pragma("unroll") for (int n = 0; n < 2; ++n) _Pragma("unroll") for (int k = 0; k < 2; ++k) \
        acc[ai][bj][m][n] = __builtin_amdgcn_mfma_f32_16x16x32_bf16(Bt[n][k], At[m][k], acc[ai][bj][m][n], 0, 0, 0); __builtin_amdgcn_s_setprio(0); } while (0)
#define G_WAIT_V(n) asm volatile("s_waitcnt vmcnt(" #n ")" ::: "memory")
#define G_WAIT_L(n) asm volatile("s_waitcnt lgkmcnt(" #n ")" ::: "memory")
#define G_BAR __builtin_amdgcn_s_barrier()
#define G_SCHED __builtin_amdgcn_sched_barrier(0)
    GU cur, nxt; int ui = 0;
    if (!gemm_unit<KIND>(X, l, 0, cur, mode)) return;
    if (KIND == K_UP) gather_voffA(X, cur, Rr, Cc, voc);
    if (KIND == K_DOWN) wait_count(X.ctl + CW_DONE + (l * 160 + cur.i0) * 16, 8u, X.ctl + CW_BAR + XB_TMO);
#define G_GATE_DMA(U, PAR) do { \
        if (KIND == K_OUT) { if (wid < 4) __builtin_amdgcn_global_load_lds((const unsigned*)(X.mod + (size_t)((l * 5 + row_mb((U).i0 * 256)) * 6 + 2) * 1024 + 256 * (U).i1 + 64 * wid + lane), \
                (LAS unsigned*)(lds + MISC_GATE + (PAR) * 1024 + wid * 256), 4, 0, 0); } \
        if (KIND == K_UP) { if (wid < 4) __builtin_amdgcn_global_load_lds((const unsigned*)((const float*)(X.wtl + (size_t)(U).i2 * CAP + (U).i3 + 64 * wid + lane) + ((U).i1 >> 2)), \
                (LAS unsigned*)(lds + MISC_GATE + (PAR) * 1024 + wid * 256), 4, 0, 0); } \
        if (KIND == K_DOWN) { if (wid < 5) __builtin_amdgcn_global_load_lds((const unsigned*)(X.mod + (size_t)((l * 5 + wid) * 6 + 5) * 1024 + 256 * (U).i1 + 4 * lane), \
                (LAS unsigned*)(lds + MISC_GATE + 2048 + (PAR) * 5120 + wid * 1024), 16, 0, 0); } } while (0)
    G_GATE_DMA(cur, 0);
    f32x4 acc[2][2][4][2];
#pragma unroll
    for (int a = 0; a < 2; ++a)
#pragma unroll
        for (int b = 0; b < 2; ++b)
#pragma unroll
            for (int m = 0; m < 4; ++m)
#pragma unroll
                for (int n = 0; n < 2; ++n) acc[a][b][m][n] = (f32x4){0.f, 0.f, 0.f, 0.f};
    bf16x8 At[4][2], B0[2][2], B1[2][2];
    const char* cA = cur.a; const char* cB = cur.b; const char* cBh = cur.bh;
    G_STAGE_B(G_SB(0, 0), cB); G_STAGE_B(G_SB(0, 1), cB + bhstep); G_STAGE(G_SA(0, 0), cA, voc[0][0], voc[0][1]); G_STAGE(G_SA(0, 1), cA + ahstep, voc[1][0], voc[1][1]);
    if (wr == 1) G_BAR;
    G_WAIT_V(2); G_BAR;
    G_STAGE_B(G_SB(1, 0), cB + kstep); G_STAGE(G_SA(1, 0), cA + kstep, voc[0][0], voc[0][1]); G_STAGE_B(G_SB(1, 1), cB + bhstep + kstep);
    G_WAIT_V(6); G_BAR;
    for (;;) {
        const bool has_next = gemm_unit<KIND>(X, l, ui + 1, nxt, mode);
        if (KIND == K_UP) { if (has_next) gather_voffA(X, nxt, Rr, Cc, von); }
        if (KIND == K_DOWN) { if (has_next) wait_count(X.ctl + CW_DONE + (l * 160 + nxt.i0) * 16, 8u, X.ctl + CW_BAR + XB_TMO); }
        const char* nA = has_next ? nxt.a : cA; const char* nB = has_next ? nxt.b : cB;
        for (int t = 0; t < nt; t += 2) {
            const bool last = (t == nt - 2);
            const char* a1 = cA + (size_t)(t + 1) * kstep;
            const char* a2 = last ? nA : cA + (size_t)(t + 2) * kstep;
            const char* b2 = last ? nB : ((t + 2) < KS ? cB : cBh) + (size_t)(t + 2) * kstep;
            const char* a3 = a2 + kstep;
            const char* b3 = last ? nB + kstep : ((t + 3) < KS ? cB : cBh) + (size_t)(t + 3) * kstep;
            unsigned v00 = voc[0][0], v01 = voc[0][1], v10 = voc[1][0], v11 = voc[1][1];
            if (KIND == K_UP) { if (last && has_next) { v00 = von[0][0]; v01 = von[0][1]; v10 = von[1][0]; v11 = von[1][1]; } }
            G_LDB(B0, 0, 0); G_LDB(B1, 0, 1); G_SCHED; G_LDA(At, 0, 0); G_STAGE(G_SA(1, 1), a1 + ahstep, voc[1][0], voc[1][1]);
            G_WAIT_V(8); G_WAIT_L(0); G_BAR; G_MMA(0, 0, At, B0); G_MMA(0, 1, At, B1); G_BAR; G_SCHED;
            G_LDA(At, 0, 1); G_STAGE_B(G_SB(0, 0), b2); G_STAGE_B(G_SB(0, 1), b2 + bhstep); G_STAGE(G_SA(0, 0), a2, v00, v01);
            G_WAIT_V(8); G_WAIT_L(0); G_BAR; G_MMA(1, 0, At, B0); G_MMA(1, 1, At, B1); G_BAR; G_SCHED;
            G_LDB(B0, 1, 0); G_LDB(B1, 1, 1); G_SCHED; G_LDA(At, 1, 0); G_STAGE(G_SA(0, 1), a2 + ahstep, v10, v11);
            G_WAIT_V(8); G_WAIT_L(0); G_BAR; G_MMA(0, 0, At, B0); G_MMA(0, 1, At, B1); G_BAR; G_SCHED;
            G_LDA(At, 1, 1); G_STAGE_B(G_SB(1, 0), b3); G_STAGE_B(G_SB(1, 1), b3 + bhstep); G_STAGE(G_SA(1, 0), a3, v00, v01);
            G_WAIT_V(8); G_WAIT_L(0); G_BAR; G_MMA(1, 0, At, B0); G_MMA(1, 1, At, B1); G_BAR; G_SCHED;
        }
        if (ALIGN_EPI) { if (wr == 0) G_BAR; }
        G_SCHED;
        gemm_epilogue<KIND>(X, l, acc, cur, wr, wc, fr, fq, ui & 1);
        if (KIND == K_UP) {
            G_WAIT_V(0); G_BAR;
            if (tid == 0) (void)__hip_atomic_fetch_add(X.ctl + CW_DONE + (l * 160 + cur.i0) * 16, 1u, __ATOMIC_RELAXED, __HIP_MEMORY_SCOPE_AGENT); }
        if (!has_next) break;
#pragma unroll
        for (int a = 0; a < 2; ++a)
#pragma unroll
            for (int b = 0; b < 2; ++b)
#pragma unroll
                for (int m = 0; m < 4; ++m)
#pragma unroll
                    for (int n = 0; n < 2; ++n) acc[a][b][m][n] = (f32x4){0.f, 0.f, 0.f, 0.f};
        cur = nxt; cA = nxt.a; cB = nxt.b; cBh = nxt.bh; ++ui;
        G_GATE_DMA(cur, ui & 1);
        if (KIND == K_UP) {
#pragma unroll
            for (int h = 0; h < 2; ++h)
#pragma unroll
                for (int i = 0; i < 2; ++i) voc[h][i] = von[h][i]; }
        if (ALIGN_EPI) { if (wr == 1) G_BAR; }
    }
    G_WAIT_V(0);
    if (!ALIGN_EPI) { if (wr == 0) G_BAR; }
    G_BAR;
#undef G_GATE_DMA
#undef G_SA
#undef G_SB
#undef G_STAGE
#undef G_STAGE_B
#undef G_LDA
#undef G_LDB
#undef G_MMA
#undef G_WAIT_V
#undef G_WAIT_L
#undef G_BAR
#undef G_SCHED
}

constexpr int L_UC = 0, L_UCB = 16384, L_PRE = 24576, L_HOUT = 90112, L_SUB = 122880;
template <bool PASS2> DI void phase_lru(const Base& B, int l) {
    const Ctx X = make_ctx(B);
    LAS unsigned char* lds = X.lds;
    LAS f32x2* UC2 = (LAS f32x2*)(lds + L_UC);
    LAS bf16_t* UCB = (LAS bf16_t*)(lds + L_UCB);
    LAS f32x2* PRE2 = (LAS f32x2*)(lds + L_PRE);
    LAS f32x2* HOUT2 = (LAS f32x2*)(lds + L_HOUT);
    LAS f32x2* SUB = (LAS f32x2*)(lds + L_SUB);
    const int tid = X.tid, lane = X.lane, w = X.wave;
    const bf16_t* Ub = X.qkv + 3 * (QKV_STRIDE / 2); const bf16_t* Gb = X.qkv + 4 * (QKV_STRIDE / 2);
    const int tp = tid >> 4, c4 = tid & 15;
    const int gm = w >> 1, eh = w & 1, r32 = lane & 31, hh = lane >> 5;
    const int ch = lane, dir = w >> 2, sub = w & 3;
    const int NU = (PASS2 && l == DEPTH - 1) ? 512 * 8 : NCHUNK * 8;
    int cblk = -1; f32x4 cw[4], cbv; bf16x8 bfr[4]; float br = 0.f, bi = 0.f, sp = 0.f;
    u32x2 pu[5], pg[2]; float pc = 0.f;
#define LRU_LOAD(UN) do { const int g_ = (UN) >> 3, blk_ = (UN) & 7, tok0_ = g_ * 64; int s0_, s1_; \
        if (g_ < 512) { s0_ = (g_ >> 7) << 13; s1_ = s0_ + SEQ; } else { s0_ = RL + ((g_ - 512) >> 2) * CTX; s1_ = s0_ + CTX; } \
        _Pragma("unroll") for (int k_ = 0; k_ < 5; ++k_) { const int row_ = tok0_ + 2 * tp + k_ - 1; \
            if (row_ >= s0_ && row_ < s1_) pu[k_] = *(const u32x2*)(Ub + (size_t)row_ * 512 + blk_ * 64 + 4 * c4); else pu[k_] = (u32x2){0u, 0u}; } \
        if (PASS2) { pg[0] = *(const u32x2*)(Gb + (size_t)(tok0_ + 2 * tp) * 512 + blk_ * 64 + 4 * c4); pg[1] = *(const u32x2*)(Gb + (size_t)(tok0_ + 2 * tp + 1) * 512 + blk_ * 64 + 4 * c4); \
            pc = X.carry[(size_t)(g_ * 2 + dir) * 512 + blk_ * 64 + ch]; } } while (0)
    const bool rebal = !PASS2 && l < DEPTH - 1 && X.G == 256;
    auto unit_of = [&](int k) -> int {
        if (!rebal) { const int u_ = X.bid + k * X.G; return u_ < NU ? u_ : NU; }
        const int nb = X.bid >= 224 ? 14 : 16;
        if (k < nb) return X.bid + k * 256;
        if (k == nb && X.bid < 192) return X.bid < 128 ? 4096 + X.bid : 224 + ((X.bid - 128) & 31) + (14 + ((X.bid - 128) >> 5)) * 256;
        return NU; };
    if (unit_of(0) < NU) LRU_LOAD(unit_of(0));
    for (int kk = 0, un = unit_of(0); un < NU; un = unit_of(++kk)) {
        const int g = un >> 3, blk = un & 7, tok0 = g * 64;
        if (blk != cblk) { cblk = blk;
#pragma unroll
            for (int k = 0; k < 4; ++k) cw[k] = *(const f32x4*)(X.conv_w + (size_t)(l * 4 + k) * 512 + blk * 64 + 4 * c4);
            cbv = *(const f32x4*)(X.conv_b + l * 512 + blk * 64 + 4 * c4);
            const bf16_t* Wt = X.gatew + (size_t)(((l * 2 + (gm >> 1)) * 2 + (gm & 1)) * 8 + blk) * 4096;
#pragma unroll
            for (int ks = 0; ks < 4; ++ks) bfr[ks] = *(const bf16x8*)(Wt + (32 * eh + r32) * 64 + 16 * ks + 8 * hh);
            br = X.lru_b_r[(l * 2 + dir) * 512 + blk * 64 + ch]; bi = X.lru_b_i[(l * 2 + dir) * 512 + blk * 64 + ch]; sp = X.sp8[(l * 2 + dir) * 512 + blk * 64 + ch]; }
        u32x2 cu[5], cgv[2]; float cc;
#pragma unroll
        for (int k = 0; k < 5; ++k) cu[k] = pu[k];
        cgv[0] = pg[0]; cgv[1] = pg[1]; cc = pc;
        { const int nu_ = unit_of(kk + 1); if (nu_ < NU) LRU_LOAD(nu_); }
        { f32x4 uf[5];
#pragma unroll
          for (int k = 0; k < 5; ++k) uf[k] = (f32x4){bflo(cu[k].x), bfhi(cu[k].x), bflo(cu[k].y), bfhi(cu[k].y)};
          f32x4 a0 = cbv, a1 = cbv;
#pragma unroll
          for (int k = 0; k < 4; ++k) { a0 += uf[k] * cw[k]; a1 += uf[k + 1] * cw[k]; }
          LAS f32x2* up = UC2 + tp * 64 + 4 * c4;
          *(LAS f32x4*)(up) = (f32x4){a0.x, a1.x, a0.y, a1.y}; *(LAS f32x4*)(up + 2) = (f32x4){a0.z, a1.z, a0.w, a1.w};
          *(LAS u32x2*)(UCB + ((c4 >> 1) * 64 + 2 * tp) * 8 + 4 * (c4 & 1)) = (u32x2){pk2(a0.x, a0.y), pk2(a0.z, a0.w)};
          *(LAS u32x2*)(UCB + ((c4 >> 1) * 64 + 2 * tp + 1) * 8 + 4 * (c4 & 1)) = (u32x2){pk2(a1.x, a1.y), pk2(a1.z, a1.w)}; }
        __syncthreads();
#pragma unroll
        for (int mb = 0; mb < 2; ++mb) { f32x16 c16;
#pragma unroll
            for (int i = 0; i < 16; ++i) c16[i] = 0.f;
#pragma unroll
            for (int ks = 0; ks < 4; ++ks) { const bf16x8 af = *(const LAS bf16x8*)(UCB + ((2 * ks + hh) * 64 + 32 * mb + r32) * 8); c16 = __builtin_amdgcn_mfma_f32_32x32x16_bf16(af, bfr[ks], c16, 0, 0, 0); }
#pragma unroll
            for (int i = 0; i < 16; i += 2) { const int tkk = 32 * mb + (i & 3) + 8 * (i >> 2) + 4 * hh;
                PRE2[(gm * 32 + (tkk >> 1)) * 64 + 32 * eh + r32] = (f32x2){c16[i], c16[i + 1]}; } }
        __syncthreads();
        float hl[16], al[16];
        { float h = 0.f, ac = 1.f; const float spl = sp * LOG2E;
          u32x2* abp = PASS2 ? nullptr : ab_ptr(X, tok0, dir) + blk * 64 + ch;
#define LRU_PAIR_LD(DIRV, kp) do { const int tpp = (DIRV) ? (8 * sub + 7 - (kp)) : (8 * sub + (kp)); \
              zrv[(kp) & 3] = PRE2[((2 * (DIRV)) * 32 + tpp) * 64 + ch]; ziv[(kp) & 3] = PRE2[((2 * (DIRV) + 1) * 32 + tpp) * 64 + ch]; ucv[(kp) & 3] = UC2[tpp * 64 + ch]; } while (0)
#define LRU_PAIR(DIRV, kp) do { const int tpp = (DIRV) ? (8 * sub + 7 - (kp)) : (8 * sub + (kp)); \
              const f32x2 zr = zrv[(kp) & 3] + br, zi = ziv[(kp) & 3] + bi, uc = ucv[(kp) & 3]; \
              f32x2 er = zr * (-LOG2E), ei = zi * (-LOG2E); \
              er.x = fexp2(er.x); er.y = fexp2(er.y); ei.x = fexp2(ei.x); ei.y = fexp2(ei.y); \
              er += 1.0f; ei += 1.0f; \
              f32x2 rg, ig; rg.x = frcp(er.x); rg.y = frcp(er.y); ig.x = frcp(ei.x); ig.y = frcp(ei.y); \
              f32x2 a = rg * (-spl); a.x = fexp2(a.x); a.y = fexp2(a.y); \
              const f32x2 om = 1.0f - a * a;                        \
              f32x2 bb; bb.x = __builtin_amdgcn_sqrtf(om.x); bb.y = __builtin_amdgcn_sqrtf(om.y); \
              bb = bb * ig * uc; \
              if (!PASS2) { const f32x2 oa = 1.0f - a;           \
                  st_wt_b64(abp + tpp * 1024, (u32x2){__builtin_bit_cast(unsigned, __builtin_convertvector((f32x2){oa.x, bb.x}, h16x2)), __builtin_bit_cast(unsigned, __builtin_convertvector((f32x2){oa.y, bb.y}, h16x2))}); } \
              const float a0 = (DIRV) ? a.y : a.x, a1 = (DIRV) ? a.x : a.y, b0 = (DIRV) ? bb.y : bb.x, b1 = (DIRV) ? bb.x : bb.y; \
              h = a0 * h + b0; ac *= a0; hl[2 * (kp)] = h; al[2 * (kp)] = ac; \
              h = a1 * h + b1; ac *= a1; hl[2 * (kp) + 1] = h; al[2 * (kp) + 1] = ac; } while (0)
          f32x2 zrv[4], ziv[4], ucv[4];
          if (dir == 0) {
#pragma unroll
              for (int k4 = 0; k4 < 8; k4 += 4) {
#pragma unroll
                  for (int kp = k4; kp < k4 + 4; ++kp) LRU_PAIR_LD(0, kp);
#pragma unroll
                  for (int kp = k4; kp < k4 + 4; ++kp) LRU_PAIR(0, kp); } }
          else {
#pragma unroll
              for (int k4 = 0; k4 < 8; k4 += 4) {
#pragma unroll
                  for (int kp = k4; kp < k4 + 4; ++kp) LRU_PAIR_LD(1, kp);
#pragma unroll
                  for (int kp = k4; kp < k4 + 4; ++kp) LRU_PAIR(1, kp); } }
#undef LRU_PAIR
#undef LRU_PAIR_LD
          SUB[(dir * 4 + sub) * 64 + ch] = (f32x2){ac, h}; }
        __syncthreads();
        if (!PASS2) {
            if (sub == (dir ? 0 : 3)) { float S = 0.f, At = 1.f;
#pragma unroll
                for (int j = 0; j < 4; ++j) { const int sb = dir ? 3 - j : j; const f32x2 ah = SUB[(dir * 4 + sb) * 64 + ch]; S = ah.x * S + ah.y; At *= ah.x; }
                st_wt_b64(X.agg + (size_t)(g * 2 + dir) * 512 + blk * 64 + ch, __builtin_bit_cast(u32x2, (f32x2){At, S})); }
        } else {
            float S = cc;
#pragma unroll
            for (int j = 0; j < 3; ++j) { const int sb = dir ? 3 - j : j; const bool take = dir ? (sb > sub) : (sb < sub); if (take) { const f32x2 ah = SUB[(dir * 4 + sb) * 64 + ch]; S = ah.x * S + ah.y; } }
#pragma unroll
            for (int kp = 0; kp < 8; ++kp) { const int tpp = dir ? (8 * sub + 7 - kp) : (8 * sub + kp);
                const float v0 = hl[2 * kp] + al[2 * kp] * S, v1 = hl[2 * kp + 1] + al[2 * kp + 1] * S;
                HOUT2[(dir * 32 + tpp) * 64 + ch] = dir ? (f32x2){v1, v0} : (f32x2){v0, v1}; }
            __syncthreads();
            { const LAS f32x2* hf = HOUT2 + tp * 64 + 4 * c4; const LAS f32x2* hr = HOUT2 + (32 + tp) * 64 + 4 * c4;
              const f32x4 f0 = *(const LAS f32x4*)(hf), f1 = *(const LAS f32x4*)(hf + 2), r0 = *(const LAS f32x4*)(hr), r1 = *(const LAS f32x4*)(hr + 2);
              const float sA0 = f0.x + r0.x, sB0 = f0.y + r0.y, sA1 = f0.z + r0.z, sB1 = f0.w + r0.w, sA2 = f1.x + r1.x, sB2 = f1.y + r1.y, sA3 = f1.z + r1.z, sB3 = f1.w + r1.w;
              const u32x2 gA = cgv[0], gB = cgv[1];
              u32x2 oA, oB;
              oA.x = pk2(gelu_tanh(bflo(gA.x)) * sA0, gelu_tanh(bfhi(gA.x)) * sA1); oA.y = pk2(gelu_tanh(bflo(gA.y)) * sA2, gelu_tanh(bfhi(gA.y)) * sA3);
              oB.x = pk2(gelu_tanh(bflo(gB.x)) * sB0, gelu_tanh(bfhi(gB.x)) * sB1); oB.y = pk2(gelu_tanh(bflo(gB.y)) * sB2, gelu_tanh(bfhi(gB.y)) * sB3);
              *(u32x2*)(X.hb + (size_t)(tok0 + 2 * tp) * D + 512 + blk * 64 + 4 * c4) = oA;
              *(u32x2*)(X.hb + (size_t)(tok0 + 2 * tp + 1) * D + 512 + blk * 64 + 4 * c4) = oB; }
        }
        __syncthreads();
    }
#undef LRU_LOAD
    if (!PASS2) {
        asm volatile("s_waitcnt vmcnt(0)" ::: "memory"); __syncthreads();
        if (X.tid == 0) (void)__hip_atomic_fetch_add(X.ctl + CW_CDONE + l * 16, 1u, __ATOMIC_RELAXED, __HIP_MEMORY_SCOPE_AGENT); }
}

DI void phase_lru2(const Base& B, int l) {
    const Ctx X = make_ctx(B);
    LAS unsigned char* lds = X.lds;
    LAS f32x2* HOUT2 = (LAS f32x2*)(lds + L_HOUT);
    LAS f32x2* SUB = (LAS f32x2*)(lds + L_SUB);
    const int tid = X.tid, lane = X.lane, w = X.wave;
    const bf16_t* Gb = X.qkv + 4 * (QKV_STRIDE / 2);
    const int tp = tid >> 4, c4 = tid & 15;
    const int ch = lane, dir = w >> 2, sub = w & 3;
    const bool cx = l < DEPTH - 1;
    const int NU = cx ? NCHUNK * 8 : 512 * 8, nbl = cx ? X.G - NCTX_OUT : X.G;
    wait_count(X.ctl + CW_CARRY + l * 64, 32u, X.ctl + CW_BAR + XB_TMO);
    const __amdgpu_buffer_rsrc_t hrs = __builtin_amdgcn_make_buffer_rsrc((void*)X.hb, 0, (int)((size_t)R * 2048), 0x00020000);
    u32x2 pab[8]; u32x2 pg[2]; float pc = 0.f;
#define LRU2_G(UN) (cx ? (((UN) >> 3) < 16 ? 512 + ((UN) >> 3) : ((UN) >> 3) - 16) : ((UN) >> 3))
#define LRU2_LOAD(UN) do { const int g_ = LRU2_G(UN), blk_ = (UN) & 7, tok0_ = g_ * 64; \
        { const u32x2* ap_ = ab_ptr(X, tok0_, dir) + blk_ * 64 + ch; _Pragma("unroll") for (int k_ = 0; k_ < 8; ++k_) pab[k_] = ap_[(dir ? 8 * sub + 7 - k_ : 8 * sub + k_) * 1024]; } \
        pg[0] = *(const u32x2*)(Gb + (size_t)(tok0_ + 2 * tp) * 512 + blk_ * 64 + 4 * c4); pg[1] = *(const u32x2*)(Gb + (size_t)(tok0_ + 2 * tp + 1) * 512 + blk_ * 64 + 4 * c4); \
        pc = X.carry[(size_t)(g_ * 2 + dir) * 512 + blk_ * 64 + ch]; } while (0)
    if (X.bid < NU) LRU2_LOAD(X.bid);
    for (int un = X.bid; un < NU; un += nbl) {
        const int g = LRU2_G(un), blk = un & 7, tok0 = g * 64;
        u32x2 cab[8]; u32x2 cgv[2]; float cc;
#pragma unroll
        for (int k = 0; k < 8; ++k) cab[k] = pab[k];
        cgv[0] = pg[0]; cgv[1] = pg[1]; cc = pc;
        if (un + nbl < NU) LRU2_LOAD(un + nbl);
        float hl[16], al[16];
        { float h = 0.f, ac = 1.f;
#pragma unroll
          for (int kp = 0; kp < 8; ++kp) {
              const unsigned w0 = dir ? cab[kp].y : cab[kp].x, w1 = dir ? cab[kp].x : cab[kp].y;
              const h16x2 f0 = __builtin_bit_cast(h16x2, w0), f1 = __builtin_bit_cast(h16x2, w1);
              const float a0 = 1.0f - (float)f0.x, a1 = 1.0f - (float)f1.x;
              h = a0 * h + (float)f0.y; ac *= a0; hl[2 * kp] = h; al[2 * kp] = ac;
              h = a1 * h + (float)f1.y; ac *= a1; hl[2 * kp + 1] = h; al[2 * kp + 1] = ac; }
          SUB[(dir * 4 + sub) * 64 + ch] = (f32x2){ac, h}; }
        __syncthreads();
        { float S = cc;
#pragma unroll
          for (int j = 0; j < 3; ++j) { const int sb = dir ? 3 - j : j; const bool take = dir ? (sb > sub) : (sb < sub); if (take) { const f32x2 ah = SUB[(dir * 4 + sb) * 64 + ch]; S = ah.x * S + ah.y; } }
#pragma unroll
          for (int kp = 0; kp < 8; ++kp) { const int tpp = dir ? (8 * sub + 7 - kp) : (8 * sub + kp);
              const float v0 = hl[2 * kp] + al[2 * kp] * S, v1 = hl[2 * kp + 1] + al[2 * kp + 1] * S;
              HOUT2[(dir * 32 + tpp) * 64 + ch] = dir ? (f32x2){v1, v0} : (f32x2){v0, v1}; } }
        __syncthreads();
        { const LAS f32x2* hf = HOUT2 + tp * 64 + 4 * c4; const LAS f32x2* hr = HOUT2 + (32 + tp) * 64 + 4 * c4;
          const f32x4 f0 = *(const LAS f32x4*)(hf), f1 = *(const LAS f32x4*)(hf + 2), r0 = *(const LAS f32x4*)(hr), r1 = *(const LAS f32x4*)(hr + 2);
          const float sA0 = f0.x + r0.x, sB0 = f0.y + r0.y, sA1 = f0.z + r0.z, sB1 = f0.w + r0.w, sA2 = f1.x + r1.x, sB2 = f1.y + r1.y, sA3 = f1.z + r1.z, sB3 = f1.w + r1.w;
          const u32x2 gA = cgv[0], gB = cgv[1];
          u32x2 oA, oB;
          oA.x = pk2(gelu_tanh(bflo(gA.x)) * sA0, gelu_tanh(bfhi(gA.x)) * sA1); oA.y = pk2(gelu_tanh(bflo(gA.y)) * sA2, gelu_tanh(bfhi(gA.y)) * sA3);
          oB.x = pk2(gelu_tanh(bflo(gB.x)) * sB0, gelu_tanh(bfhi(gB.x)) * sB1); oB.y = pk2(gelu_tanh(bflo(gB.y)) * sB2, gelu_tanh(bfhi(gB.y)) * sB3);
          if (g >= 512) {
              __builtin_amdgcn_raw_buffer_store_b64(oA, hrs, (int)(((size_t)(tok0 + 2 * tp) * D + 512 + blk * 64 + 4 * c4) * 2), 0, 16);
              __builtin_amdgcn_raw_buffer_store_b64(oB, hrs, (int)(((size_t)(tok0 + 2 * tp + 1) * D + 512 + blk * 64 + 4 * c4) * 2), 0, 16);
              asm volatile("s_waitcnt vmcnt(0)" ::: "memory"); }
          else { *(u32x2*)(X.hb + (size_t)(tok0 + 2 * tp) * D + 512 + blk * 64 + 4 * c4) = oA;
                 *(u32x2*)(X.hb + (size_t)(tok0 + 2 * tp + 1) * D + 512 + blk * 64 + 4 * c4) = oB; } }
        __syncthreads();
        if (g >= 512 && tid == 0) (void)__hip_atomic_fetch_add(X.ctl + CW_ECTX + l * 64, 1u, __ATOMIC_RELAXED, __HIP_MEMORY_SCOPE_AGENT);
    }
#undef LRU2_LOAD
#undef LRU2_G
}

DI void carry_prop(const Ctx& X, int cb) {
    LAS f32x2* XS = (LAS f32x2*)(X.lds);
    const int pi = cb >> 2, b = pi >> 1, dir = pi & 1, seg = X.tid >> 7, ch = 128 * (cb & 3) + (X.tid & 127);
    f32x2 cx[4], ah[32];
#pragma unroll
    for (int j = 0; j < 4; ++j) { const int c = dir ? 3 - j : j, g = 512 + 4 * b + c; cx[j] = X.agg[(size_t)(g * 2 + dir) * 512 + ch]; }
#pragma unroll
    for (int k = 0; k < 32; ++k) { const int j = 32 * seg + k, c = dir ? 127 - j : j, g = 128 * b + c; ah[k] = X.agg[(size_t)(g * 2 + dir) * 512 + ch]; }
    float S = 0.f;
#pragma unroll
    for (int j = 0; j < 4; ++j) { const int c = dir ? 3 - j : j, g = 512 + 4 * b + c; if (seg == 0) st_wt_b32(X.carry + (size_t)(g * 2 + dir) * 512 + ch, S); S = cx[j].x * S + cx[j].y; }
    float As = 1.f, Hs = 0.f;
#pragma unroll
    for (int k = 0; k < 32; ++k) { Hs = ah[k].x * Hs + ah[k].y; As *= ah[k].x; }
    XS[seg * 128 + (X.tid & 127)] = (f32x2){As, Hs};
    __syncthreads();
#pragma unroll
    for (int sp = 0; sp < 3; ++sp) if (sp < seg) { const f32x2 t = XS[sp * 128 + (X.tid & 127)]; S = t.x * S + t.y; }
#pragma unroll
    for (int k = 0; k < 32; ++k) { const int j = 32 * seg + k, c = dir ? 127 - j : j, g = 128 * b + c; st_wt_b32(X.carry + (size_t)(g * 2 + dir) * 512 + ch, S); S = ah[k].x * S + ah[k].y; }
    asm volatile("s_waitcnt vmcnt(0)" ::: "memory");
    __syncthreads();
}
DI void phase_carry(const Base& B, int l) {
    const Ctx X = make_ctx(B);
    wait_count(X.ctl + CW_CDONE + l * 16, (unsigned)X.G, X.ctl + CW_BAR + XB_TMO);
    carry_prop(X, X.bid - (X.G - 64));
    if (X.tid == 0) (void)__hip_atomic_fetch_add(X.ctl + CW_CARRY + l * 64, 1u, __ATOMIC_RELAXED, __HIP_MEMORY_SCOPE_AGENT);
}
DI int row0_of(int r) { const int v = r - 4; return v < 0 ? 0 : (v > 120 ? 120 : v); }
constexpr int A_STG = 16384, A_NSTG = 4, A_TBL = A_STG * A_NSTG;
#define ATT_SOFTMAX1(P)  do { float ps_ = 0.f, pt_ = 0.f; \
        _Pragma("unroll") for (int i_ = 0; i_ < 16; i_ += 2) { P[i_] = fexp2(P[i_]); P[i_ + 1] = fexp2(P[i_ + 1]); ps_ += P[i_]; pt_ += P[i_ + 1]; } \
        lrun += ps_ + pt_; } while (0)
#define ATT_PACK(P, sx) __builtin_bit_cast(bf16x8, (u32x4){pk2(P[8 * (sx)], P[8 * (sx) + 1]), pk2(P[8 * (sx) + 2], P[8 * (sx) + 3]), pk2(P[8 * (sx) + 4], P[8 * (sx) + 5]), pk2(P[8 * (sx) + 6], P[8 * (sx) + 7])})
#define ATT_DMA(stage, ktok) do { const bf16_t* kb_ = Kb + (size_t)(ktok) * 512 + 64 * h; const bf16_t* vb_ = Vb + (size_t)(ktok) * 512 + 64 * h; \
        __builtin_amdgcn_global_load_lds((const unsigned*)(kb_ + kso), (LAS unsigned*)(lds + (stage) * A_STG + w * 1024), 16, 0, 0); \
        __builtin_amdgcn_global_load_lds((const unsigned*)(vb_ + vso), (LAS unsigned*)(lds + (stage) * A_STG + 8192 + w * 1024), 16, 0, 0); } while (0)
#define ATT_KTOK(st) ((st) < nwin ? (b * SEQ + 64 * (krlo + (st))) : (RL + b * CTX + 64 * ((st) - nwin)))
#define ATT_VREAD(VB, IMM0, VL, VH) do { \
        _Pragma("unroll") for (int db_ = 0; db_ < 2; ++db_) _Pragma("unroll") for (int sx_ = 0; sx_ < 2; ++sx_) { \
            asm volatile("ds_read_b64_tr_b16 %0, %1 offset:%c2" : "=&v"(VL[db_][sx_]) : "v"(VB), "i"((IMM0) + db_ * 4096 + sx_ * 1024) : "memory"); \
            asm volatile("ds_read_b64_tr_b16 %0, %1 offset:%c2" : "=&v"(VH[db_][sx_]) : "v"(VB), "i"((IMM0) + db_ * 4096 + sx_ * 1024 + 512) : "memory"); } } while (0)
#define ATT_LGKM0() do { asm volatile("s_waitcnt lgkmcnt(0)" ::: "memory"); __builtin_amdgcn_sched_barrier(0); } while (0)
#define ATT_PVMMA(VL, VH, PF0, PF1) do { \
        _Pragma("unroll") for (int sx_ = 0; sx_ < 2; ++sx_) { \
            const bf16x8 va_ = (bf16x8){VL[0][sx_][0], VL[0][sx_][1], VL[0][sx_][2], VL[0][sx_][3], VH[0][sx_][0], VH[0][sx_][1], VH[0][sx_][2], VH[0][sx_][3]}; \
            const bf16x8 vb_ = (bf16x8){VL[1][sx_][0], VL[1][sx_][1], VL[1][sx_][2], VL[1][sx_][3], VH[1][sx_][0], VH[1][sx_][1], VH[1][sx_][2], VH[1][sx_][3]}; \
            o0 = __builtin_amdgcn_mfma_f32_32x32x16_bf16(va_, sx_ ? (PF1) : (PF0), o0, 0, 0, 0); o1 = __builtin_amdgcn_mfma_f32_32x32x16_bf16(vb_, sx_ ? (PF1) : (PF0), o1, 0, 0, 0); } } while (0)
template <int ST> DI void att_step(LAS unsigned char* lds, int s, int nsteps, int nwin, int krlo, int wlo, int whi, int myr0, int qrow, int cs, int r32, int hh, unsigned vwin, unsigned vctx,
                                   unsigned kso, unsigned vso, int w, int h, int b, const bf16_t* Kb, const bf16_t* Vb, const LAS float* TBL, const unsigned (&bp)[4], const bf16x8 (&qf)[4],
                                   f32x16& o0, f32x16& o1, float mref, float& lrun) {
    const int rem = nsteps - 1 - s;
    TP_BEGIN(20, tpa_)
    if (rem >= 2) asm volatile("s_waitcnt vmcnt(4) lgkmcnt(0)" ::: "memory"); else if (rem == 1) asm volatile("s_waitcnt vmcnt(2) lgkmcnt(0)" ::: "memory"); else asm volatile("s_waitcnt vmcnt(0) lgkmcnt(0)" ::: "memory");
    TP_BEGIN(23, tpd_)
    __builtin_amdgcn_s_barrier(); asm volatile("" ::: "memory");
    TP_END(20, tpa_, lds); TP_END(23, tpd_, lds);
    TP_BEGIN(21, tpb_)
    if (s + 3 < nsteps) ATT_DMA((ST + 3) & 3, ATT_KTOK(s + 3));
    const LAS unsigned char* Kt = lds + ST * A_STG;
    if (s < nwin) {
        const int kr = krlo + s;
        if (kr >= wlo && kr <= whi) {
            const int ri = (kr >= myr0 && kr < myr0 + 8) ? (kr - qrow + 7) : 15;
            const LAS float* trow = TBL + ri * 32;
            f32x16 p; bf16x8 kf[4]; s16x4 vl[2][2], vh[2][2];
            unsigned b4[16];
            { unsigned w0 = bp[0], w1 = bp[1], w2 = bp[2], w3 = bp[3]; asm volatile("" : "+v"(w0), "+v"(w1), "+v"(w2), "+v"(w3));
#pragma unroll
              for (int i = 0; i < 16; ++i) { const unsigned wv = (i >> 2) == 0 ? w0 : ((i >> 2) == 1 ? w1 : ((i >> 2) == 2 ? w2 : w3)); b4[i] = (wv >> (8 * (i & 3))) & 0xffu; } }
            TP_BEGIN(22, tpc_)
#pragma unroll
            for (int i = 0; i < 16; ++i) p[i] = *(const LAS float*)((const LAS unsigned char*)trow + b4[i]);
#pragma unroll
            for (int ks = 0; ks < 4; ++ks) kf[ks] = *(const LAS bf16x8*)(Kt + (2 * ks + hh) * 1024 + (cs + r32) * 16);
            ATT_VREAD(vwin, ST * A_STG + 8192, vl, vh);
            ATT_LGKM0();
            TP_END(22, tpc_, lds);
#pragma unroll
            for (int ks = 0; ks < 4; ++ks) p = __builtin_amdgcn_mfma_f32_32x32x16_bf16(kf[ks], qf[ks], p, 0, 0, 0);
            ATT_SOFTMAX1(p);
            const bf16x8 pf0 = ATT_PACK(p, 0), pf1 = ATT_PACK(p, 1);
            ATT_PVMMA(vl, vh, pf0, pf1);
        }
    } else {
        f32x16 pa, pb; bf16x8 kf0[4], kf1[4]; s16x4 vl0[2][2], vh0[2][2], vl1[2][2], vh1[2][2];
        float nm = -mref; asm volatile("" : "+v"(nm));
#pragma unroll
        for (int ks = 0; ks < 4; ++ks) kf0[ks] = *(const LAS bf16x8*)(Kt + (2 * ks + hh) * 1024 + r32 * 16);
        ATT_VREAD(vctx, ST * A_STG + 8192, vl0, vh0);
        ATT_LGKM0();
#pragma unroll
        for (int i = 0; i < 16; ++i) pa[i] = nm;
#pragma unroll
        for (int ks = 0; ks < 4; ++ks) pa = __builtin_amdgcn_mfma_f32_32x32x16_bf16(kf0[ks], qf[ks], pa, 0, 0, 0);
        __builtin_amdgcn_sched_barrier(0);
#pragma unroll
        for (int ks = 0; ks < 4; ++ks) kf1[ks] = *(const LAS bf16x8*)(Kt + (2 * ks + hh) * 1024 + (32 + r32) * 16);
        ATT_VREAD(vctx, ST * A_STG + 8192 + 2048, vl1, vh1);
        __builtin_amdgcn_sched_barrier(0);
        ATT_SOFTMAX1(pa);
        { const bf16x8 pf0 = ATT_PACK(pa, 0), pf1 = ATT_PACK(pa, 1); ATT_PVMMA(vl0, vh0, pf0, pf1); }
        ATT_LGKM0();
#pragma unroll
        for (int i = 0; i < 16; ++i) pb[i] = nm;
#pragma unroll
        for (int ks = 0; ks < 4; ++ks) pb = __builtin_amdgcn_mfma_f32_32x32x16_bf16(kf1[ks], qf[ks], pb, 0, 0, 0);
        ATT_SOFTMAX1(pb);
        { const bf16x8 pf0 = ATT_PACK(pb, 0), pf1 = ATT_PACK(pb, 1); ATT_PVMMA(vl1, vh1, pf0, pf1); }
    }
    if (TPROF == 21) { asm volatile("s_nop 0" :: "v"(o0[0]), "v"(o1[0]), "v"(lrun)); }
    TP_END(21, tpb_, lds);
}
DI void phase_attn(const Base& B, int l, int mode) {
    const Ctx X = make_ctx(B);
    LAS unsigned char* lds = X.lds;
    LAS float* TBL = (LAS float*)(lds + A_TBL);
    const int tid = X.tid, lane = X.lane, w = X.wave, r32 = lane & 31, hh = lane >> 5;
    const bf16_t* Qb = X.qkv; const bf16_t* Kb = X.qkv + (QKV_STRIDE / 2); const bf16_t* Vb = X.qkv + 2 * (QKV_STRIDE / 2);
    const int nunits = mode == 1 ? 1056 : ((l == DEPTH - 1 || mode == 0) ? 1024 : 1056), un0 = mode == 1 ? 1024 + X.bid - (X.G - 32) : X.bid;
    const unsigned kso = (unsigned)(lane * 512 + 8 * w), vso = (unsigned)((16 * (w & 3) + (lane >> 2)) * 512 + 32 * (w >> 2) + 8 * (lane & 3));
    const unsigned vlane = (unsigned)((4 * hh + ((lane & 15) >> 2)) * 64 + (16 * ((lane >> 4) & 1) + 4 * (lane & 3)) * 2);
    const unsigned ldsb = (unsigned)(size_t)lds;
    const int rp = w >> 2, jb = w & 3, qcol = 16 * jb + (r32 & 15);
    int cs = 16 * jb - 8; cs = cs < 0 ? 0 : (cs > 32 ? 32 : cs);
    unsigned bp[4] = {0u, 0u, 0u, 0u};
    { int c0 = qcol - 8; c0 = c0 < 0 ? 0 : (c0 > 48 ? 48 : c0);
#pragma unroll
      for (int i = 0; i < 16; ++i) { const int kc = cs + (i & 3) + 8 * (i >> 2) + 4 * hh; const int bi = (kc >= c0 && kc < c0 + 16) ? (kc - qcol + 15) : 31; bp[i >> 2] |= (unsigned)(bi * 4) << (8 * (i & 3)); } }
    const unsigned vctx = ldsb + vlane, vwin = vctx + (unsigned)cs * 64u;
    float mref;
    { float gq = fabsf(X.q_gain[l * 64 + lane]), gk = fabsf(X.k_gain[l * 64 + lane]);
#pragma unroll
      for (int o = 1; o < 64; o <<= 1) { gq = fmaxf(gq, shflx(gq, o, lane)); gk = fmaxf(gk, shflx(gk, o, lane)); }
      mref = 8.0f * LOG2E * gq * gk; }
    int tbl_h = -1;
    auto q_load = [&](int u_, bf16x8 (&q)[4]) { int qt_, h_;
        if (u_ < 1024) { h_ = (u_ >> 5) & 7; qt_ = (u_ >> 8) * SEQ + 64 * (4 * (u_ & 31) + 2 * rp + (r32 >> 4)) + qcol; } else { const int v_ = u_ - 1024; h_ = v_ & 7; qt_ = RL + (v_ >> 3) * CTX + 32 * w + r32; }
#pragma unroll
        for (int ks = 0; ks < 4; ++ks) q[ks] = *(const bf16x8*)(Qb + (size_t)qt_ * 512 + 64 * h_ + 16 * ks + 8 * hh); };
    bf16x8 qf[4], qn[4];
#pragma unroll
    for (int ks = 0; ks < 4; ++ks) { qf[ks] = (bf16x8){0, 0, 0, 0, 0, 0, 0, 0}; qn[ks] = qf[ks]; }
    if (un0 < nunits) q_load(un0, qf);
    for (int un = un0; un < nunits; un += X.G) {
        const bool lat = un < 1024;
        int b, h, r0 = 0;
        if (lat) { b = un >> 8; h = (un >> 5) & 7; r0 = 4 * (un & 31); } else { const int v = un - 1024; b = v >> 3; h = v & 7; }
        int krlo = 0, nwin = 0, qrow = 0, myr0 = 0, wlo = 0, whi = 0, qtok;
        if (lat) { krlo = row0_of(r0); nwin = row0_of(r0 + 3) + 8 - krlo; const int ra = r0 + 2 * rp; qrow = ra + (r32 >> 4); myr0 = row0_of(qrow); wlo = row0_of(ra); whi = row0_of(ra + 1) + 7;
            qtok = b * SEQ + 64 * qrow + qcol; }
        else qtok = RL + b * CTX + 32 * w + r32;
        const int nsteps = nwin + 4;
        ATT_DMA(0, ATT_KTOK(0)); ATT_DMA(1, ATT_KTOK(1)); ATT_DMA(2, ATT_KTOK(2));
        if (lat && h != tbl_h) { tbl_h = h;
            for (int i = tid; i < 16 * 32; i += 512) { const int ri = i >> 5, ci = i & 31; TBL[i] = (ci < 31 && ri < 15) ? X.na_bias[((size_t)(l * 8 + h) * 15 + ri) * 31 + ci] * LOG2E - mref : NEGBIG; } }
        const bool more = un + X.G < nunits;
        if (more) q_load(un + X.G, qn);
        f32x16 o0, o1;
#pragma unroll
        for (int i = 0; i < 16; ++i) { o0[i] = 0.f; o1[i] = 0.f; }
        float lrun = 0.f;
#define ATT_STEP(ST, sv) att_step<ST>(lds, sv, nsteps, nwin, krlo, wlo, whi, myr0, qrow, cs, r32, hh, vwin, vctx, kso, vso, w, h, b, Kb, Vb, TBL, bp, qf, o0, o1, mref, lrun)
        for (int s0 = 0; s0 < nsteps; s0 += 4) {
            ATT_STEP(0, s0);
            if (s0 + 1 < nsteps) ATT_STEP(1, s0 + 1);
            if (s0 + 2 < nsteps) ATT_STEP(2, s0 + 2);
            if (s0 + 3 < nsteps) ATT_STEP(3, s0 + 3);
        }
#undef ATT_STEP
        asm volatile("" ::: "memory"); __builtin_amdgcn_s_barrier(); asm volatile("" ::: "memory");
        if (more) {
#pragma unroll
            for (int ks = 0; ks < 4; ++ks) asm volatile("" : "+v"(qn[ks])); }
        { const float lt = lrun + shflx(lrun, 32, lane), inv = frcp(lt);
          bf16_t* op = X.hb + (size_t)qtok * D + 64 * h + 4 * hh;
#pragma unroll
          for (int gq = 0; gq < 4; ++gq) { u32x2 a, c; a.x = pk2(o0[4 * gq] * inv, o0[4 * gq + 1] * inv); a.y = pk2(o0[4 * gq + 2] * inv, o0[4 * gq + 3] * inv);
              c.x = pk2(o1[4 * gq] * inv, o1[4 * gq + 1] * inv); c.y = pk2(o1[4 * gq + 2] * inv, o1[4 * gq + 3] * inv);
              if (lat) { *(u32x2*)(op + 8 * gq) = a; *(u32x2*)(op + 32 + 8 * gq) = c; }
              else { st_wt_b64(op + 8 * gq, a); st_wt_b64(op + 32 + 8 * gq, c); } } }
        if (!lat) { asm volatile("s_waitcnt vmcnt(0)" ::: "memory"); __builtin_amdgcn_s_barrier(); asm volatile("" ::: "memory");
            if (tid == 0) (void)__hip_atomic_fetch_add(X.ctl + CW_ECTX + l * 64, 1u, __ATOMIC_RELAXED, __HIP_MEMORY_SCOPE_AGENT); }
#pragma unroll
        for (int ks = 0; ks < 4; ++ks) qf[ks] = qn[ks];
    }
}
#undef ATT_SOFTMAX1
#undef ATT_PACK
#undef ATT_VREAD
#undef ATT_LGKM0
#undef ATT_PVMMA
#undef ATT_DMA
#undef ATT_KTOK

constexpr int G_RWP = 1032, G_RWH = 0, G_RWL = G_RWH + 16 * G_RWP * 2, G_GM = G_RWL + 16 * G_RWP * 2, G_SH = G_GM + 5 * 1024 * 4, G_LG = G_SH + 5 * 1024 * 4,
              G_SELC = G_LG + 272 * 16 * 4, G_SELW = G_SELC + 272 * 4, G_CNT = G_SELW + 272 * 8, G_BASE = G_CNT + 128;
static_assert(G_BASE + 128 <= LDS_MISC, "router LDS map");
DI void phase_router(const Base& B, int l, int dummy) {
    Ctx X = make_ctx(B);
    if (dummy) { X.list += 13 * (MiB / 4); X.wtl += 13 * (MiB / 8); }
    const int cwc = CW_CLS + (dummy ? 128 : 0) + l * 32;
    LAS unsigned char* lds = X.lds;
    LAS bf16_t* RWH = (LAS bf16_t*)(lds + G_RWH); LAS bf16_t* RWL = (LAS bf16_t*)(lds + G_RWL);
    LAS float* GM = (LAS float*)(lds + G_GM); LAS float* SHT = (LAS float*)(lds + G_SH);
    LAS float* LG = (LAS float*)(lds + G_LG);
    LAS int* SELC = (LAS int*)(lds + G_SELC);
    LAS f32x2* SELW = (LAS f32x2*)(lds + G_SELW);
    LAS int* CNT = (LAS int*)(lds + G_CNT); LAS int* BASE = (LAS int*)(lds + G_BASE);
    const int tid = X.tid, lane = X.lane, w = X.wave;
#pragma unroll 1
    for (int i0 = tid; i0 < 16384; i0 += 8 * 512) { float wv[8];
#pragma unroll
        for (int k = 0; k < 8; ++k) wv[k] = X.router_w[i0 + 512 * k];
#pragma unroll
        for (int k = 0; k < 8; ++k) { const int i = i0 + 512 * k; const unsigned hi = pk2(wv[k], 0.f) & 0xffffu; const unsigned lo = pk2(wv[k] - bflo(hi), 0.f) & 0xffffu;
            RWH[(i & 15) * G_RWP + (i >> 4)] = (bf16_t)hi; RWL[(i & 15) * G_RWP + (i >> 4)] = (bf16_t)lo; } }
    { float gn[10], s0[10], s1[10];
#pragma unroll
      for (int k = 0; k < 10; ++k) { const int i = tid + 512 * k, mb = i >> 10, c = i & 1023; const float* sh = X.mod + (size_t)((l * 5 + mb) * 6 + 3) * 1024;
          gn[k] = X.norm_ffn[l * D + c]; s1[k] = sh[1024 + c]; s0[k] = sh[c]; }
      asm volatile("" : "+v"(gn[9]), "+v"(s0[9]), "+v"(s1[9]));
#pragma unroll
      for (int k = 0; k < 10; ++k) { const int i = tid + 512 * k; GM[i] = gn[k] * (s1[k] + 1.0f); SHT[i] = s0[k]; } }
    if (tid < 32) CNT[tid] = 0;
    __syncthreads();
    int row0, nrows;
    { const int NG = (l < DEPTH - 1 ? R : RL) / 16, g0 = (int)(((long)X.bid * NG) / X.G), g1 = (int)(((long)(X.bid + 1) * NG) / X.G); row0 = 16 * g0; nrows = 16 * (g1 - g0); }
    const int r16 = lane & 15, kb = lane >> 4;
    for (int gi = w; gi * 16 < nrows; gi += 8) {
        const int rl = gi * 16 + r16; const bool valid = rl < nrows; const int row = row0 + (valid ? rl : nrows - 1), mb = row_mb(row);
        const bf16_t* xr = X.xb + (size_t)row * D + 8 * kb;
        float ss = 0.f;
#pragma unroll
        for (int c0 = 0; c0 < 32; c0 += 8) { u32x4 raw[8];
#pragma unroll
            for (int c = 0; c < 8; ++c) raw[c] = *(const u32x4*)(xr + 32 * (c0 + c));
#pragma unroll
            for (int c = 0; c < 8; ++c) { f32x4 a, b; unpack8(raw[c], a, b); ss += ((a.x * a.x + a.y * a.y) + (a.z * a.z + a.w * a.w)) + ((b.x * b.x + b.y * b.y) + (b.z * b.z + b.w * b.w)); } }
        ss += shflx(ss, 16, lane); ss += shflx(ss, 32, lane);
        const float rsd = __builtin_amdgcn_rsqf(ss * (1.0f / D) + EPS);
        bf16_t* orow = X.hb + (size_t)row * D + 8 * kb;
        const LAS float* gmr = GM + mb * 1024 + 8 * kb; const LAS float* shr = SHT + mb * 1024 + 8 * kb;
        const LAS bf16_t* bhp = RWH + r16 * G_RWP + 8 * kb; const LAS bf16_t* blp = RWL + r16 * G_RWP + 8 * kb;
        f32x4 dacc = (f32x4){0.f, 0.f, 0.f, 0.f};
#pragma unroll
        for (int c0 = 0; c0 < 32; c0 += 8) { u32x4 raw[8];
#pragma unroll
            for (int c = 0; c < 8; ++c) raw[c] = *(const u32x4*)(xr + 32 * (c0 + c));
#pragma unroll
            for (int cc = 0; cc < 8; ++cc) { const int c = c0 + cc; f32x4 a, b; unpack8(raw[cc], a, b);
                const f32x4 g0 = *(const LAS f32x4*)(gmr + 32 * c), g1 = *(const LAS f32x4*)(gmr + 32 * c + 4), h0 = *(const LAS f32x4*)(shr + 32 * c), h1 = *(const LAS f32x4*)(shr + 32 * c + 4);
                const f32x4 y0 = a * rsd * g0 + h0, y1 = b * rsd * g1 + h1;
                const u32x4 hw = pack8(y0, y1);
                if (valid) *(u32x4*)(orow + 32 * c) = hw;
                f32x4 q0, q1; unpack8(hw, q0, q1);
                const u32x4 lw = pack8(y0 - q0, y1 - q1);
                const bf16x8 bh = *(const LAS bf16x8*)(bhp + 32 * c), bl = *(const LAS bf16x8*)(blp + 32 * c);
                const bf16x8 ah = __builtin_bit_cast(bf16x8, hw), al = __builtin_bit_cast(bf16x8, lw);
                dacc = __builtin_amdgcn_mfma_f32_16x16x32_bf16(ah, bh, dacc, 0, 0, 0);
                dacc = __builtin_amdgcn_mfma_f32_16x16x32_bf16(al, bh, dacc, 0, 0, 0);
                dacc = __builtin_amdgcn_mfma_f32_16x16x32_bf16(ah, bl, dacc, 0, 0, 0); }
            asm volatile("" : "+v"(dacc) : : "memory"); }
#pragma unroll
        for (int i = 0; i < 4; ++i) { const int rr = gi * 16 + 4 * kb + i; if (rr < nrows) LG[rr * 16 + r16] = dacc[i]; }
    }
    __syncthreads();
    if (tid < nrows) {
        float aff[16], sel[16];
#pragma unroll
        for (int q = 0; q < 4; ++q) { const f32x4 t4 = *(const LAS f32x4*)(LG + tid * 16 + 4 * q); const f32x4 rb4 = *(const f32x4*)(X.router_b + 4 * q);
            aff[4 * q] = sigmoidf_(t4.x); aff[4 * q + 1] = sigmoidf_(t4.y); aff[4 * q + 2] = sigmoidf_(t4.z); aff[4 * q + 3] = sigmoidf_(t4.w);
            sel[4 * q] = aff[4 * q] + rb4.x; sel[4 * q + 1] = aff[4 * q + 1] + rb4.y; sel[4 * q + 2] = aff[4 * q + 2] + rb4.z; sel[4 * q + 3] = aff[4 * q + 3] + rb4.w; }
        int best = 0; float bs = 0.f;
#pragma unroll
        for (int g = 0; g < 4; ++g) { float m1 = sel[4 * g], m2 = -3.0e38f;
#pragma unroll
            for (int j = 1; j < 4; ++j) { const float t = sel[4 * g + j]; if (t > m1) { m2 = m1; m1 = t; } else if (t > m2) m2 = t; }
            const float gs = m1 + m2; if (g == 0 || gs > bs) { bs = gs; best = g; } }
        float s4[4], a4[4];
#pragma unroll
        for (int j = 0; j < 4; ++j) { s4[j] = best == 0 ? sel[j] : (best == 1 ? sel[4 + j] : (best == 2 ? sel[8 + j] : sel[12 + j])); a4[j] = best == 0 ? aff[j] : (best == 1 ? aff[4 + j] : (best == 2 ? aff[8 + j] : aff[12 + j])); }
        int i1 = 0; float v1 = s4[0];
#pragma unroll
        for (int j = 1; j < 4; ++j) if (s4[j] > v1) { v1 = s4[j]; i1 = j; }
        int i2 = -1; float v2 = 0.f;
#pragma unroll
        for (int j = 0; j < 4; ++j) if (j != i1 && (i2 < 0 || s4[j] > v2)) { v2 = s4[j]; i2 = j; }
        const int lo = i1 < i2 ? i1 : i2, hi = i1 < i2 ? i2 : i1;
        const float alo = lo == 0 ? a4[0] : (lo == 1 ? a4[1] : a4[2]), ahi = hi == 1 ? a4[1] : (hi == 2 ? a4[2] : a4[3]);
        const float inv = frcp(alo + ahi);
        const int pidx = lo == 0 ? hi - 1 : (lo == 1 ? hi + 1 : 5);
        const int cls = best * 6 + pidx;
        SELC[tid] = cls; SELW[tid] = (f32x2){alo * inv, ahi * inv};
        atomicAdd((int*)&CNT[cls], 1);
    }
    __syncthreads();
    if (tid < NCLS) BASE[tid] = (int)__hip_atomic_fetch_add(X.ctl + cwc + tid, (unsigned)CNT[tid], __ATOMIC_RELAXED, __HIP_MEMORY_SCOPE_AGENT);
    __syncthreads();
    if (tid < nrows) { const int c = SELC[tid]; int rank = 0; for (int j = 0; j < tid; ++j) rank += (SELC[j] == c) ? 1 : 0;
        const int pos = BASE[c] + rank; X.list[(size_t)c * CAP + pos] = row0 + tid; X.wtl[(size_t)c * CAP + pos] = SELW[tid]; }
    __syncthreads();
}

constexpr int PH_PER_LAYER = 9, N_PHASES = 1 + DEPTH * PH_PER_LAYER;
__global__ void __launch_bounds__(512, 2) k_fwd(Args a) {
    extern __shared__ __attribute__((aligned(16))) unsigned char lds_raw[];
    Base X;
    X.lds = (LAS unsigned char*)lds_raw;
    X.tid = threadIdx.x; X.lane = X.tid & 63; X.wave = __builtin_amdgcn_readfirstlane(X.tid >> 6); X.bid = blockIdx.x; X.G = gridDim.x;
    for (int u = X.tid; u < (LDS_BYTES - LDS_MISC) / 4; u += 512) ((LAS unsigned*)(X.lds + LDS_MISC))[u] = 0u;
    __syncthreads();
#if MK_MULTI
#define GRID_BAR() do { } while (0)
#else
    XcdBarrier bar = xcd_barrier_post((unsigned*)(a.ws + WS_CTL) + CW_BAR, (volatile LAS unsigned*)(X.lds + MISC_BAR));
#define GRID_BAR() do { TP_BEGIN(1, tpb_) xcd_barrier(bar); TP_END(1, tpb_, X.lds); } while (0)
#define TPW(id, ...) do { TP_BEGIN(id, tpw_) __VA_ARGS__; TP_END(id, tpw_, X.lds); } while (0)
#endif
    const int lo = a.ph_lo, hi = a.ph_hi;
#define IN(k) (lo <= (k) && (k) < hi)
#define SEAM(k) SEAMI(0, k)
#define SEAMI(idx, k) do { if (IN((k) + 1)) { TP_BEGIN(30 + (idx), tps_) GRID_BAR(); TP_END(30 + (idx), tps_, X.lds); } } while (0)
#define RUNPH(idx, k, call) do { if (PHM(idx) && IN(k)) { TPW(10 + (idx), call); if (PROBE_REP == (idx)) { GRID_BAR(); call; } SEAMI(idx, k); } } while (0)
    RUNPH(0, 0, phase_p0(X));
    for (int l = 0; l < DEPTH; ++l) {
        const int pb = 1 + l * PH_PER_LAYER;
        if (PHM(1) && IN(pb + 0)) {
            const bool ctxw_a = !MK_MULTI && IN(pb + 1) && X.bid >= X.G - NCTX_IN;
            if (ctxw_a) xcd_barrier_arrive(bar);
            TPW(11, if (phase_norm1(X, l)) gemm_phase<K_IN, true>(X, l, 1));
            if (ctxw_a) xcd_barrier_wait(bar); else SEAMI(1, pb + 0); }
        RUNPH(2, pb + 1, (gemm_phase<K_IN, true>(X, l, 0)));
        const bool ctx_in_c = X.G == 256 && l < DEPTH - 1;
        if (PHM(3) && IN(pb + 2)) { TPW(13, if (ctx_in_c && X.bid >= X.G - 32) phase_attn(X, l, 1); phase_lru<false>(X, l); if (X.bid >= X.G - 64 && X.bid < X.G - 32) phase_carry(X, l)); if (MK_MULTI) SEAMI(3, pb + 2); }
        if (PHM(4) && IN(pb + 3)) { TPW(14, phase_attn(X, l, ctx_in_c ? 0 : 2)); if (MK_MULTI) SEAMI(4, pb + 3); }
        if (PHM(5) && IN(pb + 4)) {
            TP_BEGIN(15, tpe_)
            if (l < DEPTH - 1 && X.bid >= (int)gridDim.x - NCTX_OUT) { unsigned* ctl = (unsigned*)(a.ws + WS_CTL);
                wait_count(ctl + CW_ECTX + l * 64, 160u, ctl + CW_BAR + XB_TMO); gemm_phase<K_OUT, EPI_ALIGN_RMW>(X, l, 1); }
            else phase_lru2(X, l);
            TP_END(15, tpe_, X.lds);
            SEAMI(5, pb + 4); }
        RUNPH(6, pb + 5, (gemm_phase<K_OUT, EPI_ALIGN_RMW>(X, l, 0)));
        if (PHM(7) && IN(pb + 6)) { TPW(17, phase_router(X, l, 0)); if (PROBE_REP == 7) { GRID_BAR(); phase_router(X, l, 1); } SEAMI(7, pb + 6); }
        if (PHM(8) && IN(pb + 7)) { TPW(18, (gemm_phase<K_UP, true>(X, l, 0))); if (MK_MULTI || !IN(pb + 8)) { } }
        if (PHM(9) && IN(pb + 8)) { TPW(19, (gemm_phase<K_DOWN, EPI_ALIGN_RMW>(X, l, 0))); if (l < DEPTH - 1) TPW(40, phase_conv(X, l + 1)); SEAMI(9, pb + 8); }
    }
#undef RUNPH
#undef IN
#undef SEAM
#if TPROF >= 0 && !MK_MULTI
    {
        __syncthreads();
        unsigned* ctl = (unsigned*)(a.ws + WS_CTL);
        const unsigned mine = *(LAS unsigned*)(X.lds + MISC_TP);
        unsigned long long target = (unsigned long long)mine * TPROF_AMP;
        if (TPROF_MEAN) {
            if (X.tid == 0) (void)__hip_atomic_fetch_add(ctl + CW_TP, mine, __ATOMIC_RELAXED, __HIP_MEMORY_SCOPE_AGENT);
            xcd_barrier(bar);
            target = 0ull;
            if (X.bid == 0) target = (unsigned long long)__hip_atomic_load(ctl + CW_TP, __ATOMIC_RELAXED, __HIP_MEMORY_SCOPE_AGENT) * TPROF_AMP / (unsigned)X.G;
        }
        if (X.tid == 0 && target > 0ull) { if (target > 1000000ull) target = 1000000ull; const unsigned t0 = tp_now(); while ((unsigned long long)(tp_now() - t0) < target) __builtin_amdgcn_s_sleep(10); }
    }
#endif
}

extern "C" void kernel_launch(void* const* d_in, const int* in_sizes, int n_in, void* d_out, int out_size, void* d_ws, size_t ws_size, hipStream_t stream) {
    static int grid = 0;
    if (grid == 0) {
        if (n_in != 25 || out_size != RL * D || ws_size < WS_END) { fprintf(stderr, "kernel_launch: unexpected shapes (n_in %d out %d ws %zu)\n", n_in, out_size, ws_size); grid = -1; return; }
        int dev = 0, cus = 0, per_cu = 0;
        if (hipGetDevice(&dev) != hipSuccess || hipDeviceGetAttribute(&cus, hipDeviceAttributeMultiprocessorCount, dev) != hipSuccess) { grid = -1; return; }
        if (hipFuncSetAttribute((const void*)k_fwd, hipFuncAttributeMaxDynamicSharedMemorySize, LDS_BYTES) != hipSuccess) { fprintf(stderr, "kernel_launch: hipFuncSetAttribute failed\n"); grid = -1; return; }
        if (hipOccupancyMaxActiveBlocksPerMultiprocessor(&per_cu, (const void*)k_fwd, 512, LDS_BYTES) != hipSuccess || per_cu < 1) fprintf(stderr, "kernel_launch: occupancy query says %d\n", per_cu);
        (void)hipGetLastError();
        grid = cus < 256 ? cus : 256;
    }
    if (grid < 0) return;
    (void)hipMemsetAsync((char*)d_ws + WS_CTL, 0, CTL_BYTES, stream);
    Args a{};
    for (int i = 0; i < 25; ++i) a.in[i] = (const float*)d_in[i];
    a.out = (float*)d_out; a.ws = (unsigned char*)d_ws;
#if MK_MULTI
    for (int p = 0; p < N_PHASES; ++p) { a.ph_lo = p; a.ph_hi = p + 1; hipLaunchKernelGGL(k_fwd, dim3(grid), dim3(512), LDS_BYTES, stream, a); }
#else
    a.ph_lo = 0; a.ph_hi = N_PHASES;
    hipLaunchKernelGGL(k_fwd, dim3(grid), dim3(512), LDS_BYTES, stream, a);
#endif
}
```

```cpp
#include <hip/hip_runtime.h>
#include <cstdio>
#include <cstdint>

#ifndef PH_MASK
#define PH_MASK 0x3ff
#endif
#define PHM(i) ((PH_MASK >> (i)) & 1)
#ifndef EPI_ALIGN_RMW
#define EPI_ALIGN_RMW true
#endif
#ifndef PROBE_REP
#define PROBE_REP -1
#endif
#ifndef TPROF
#define TPROF -1
#endif
#ifndef TPROF_AMP
#define TPROF_AMP 2
#endif
#ifndef TPROF_MEAN
#define TPROF_MEAN 1
#endif
#ifndef MK_MULTI
#define MK_MULTI 0
#endif

#define LAS __attribute__((address_space(3)))
#define DI __device__ __forceinline__
typedef unsigned short bf16_t;
typedef short bf16x8 __attribute__((ext_vector_type(8)));
typedef short s16x4 __attribute__((ext_vector_type(4)));
typedef short v4i16_t __attribute__((ext_vector_type(4)));
typedef float f32x2 __attribute__((ext_vector_type(2)));
typedef float f32x4 __attribute__((ext_vector_type(4)));
typedef float f32x16 __attribute__((ext_vector_type(16)));
typedef unsigned u32x2 __attribute__((ext_vector_type(2)));
typedef unsigned u32x4 __attribute__((ext_vector_type(4)));
typedef __bf16 bf16x2_t __attribute__((ext_vector_type(2)));

constexpr int D = 1024, DEPTH = 4, SEQ = 8192, NB = 4, CTX = 256;
constexpr int RL = NB * SEQ;
constexpr int RC = NB * CTX;
constexpr int R = RL + RC;
constexpr int NIN = 2560;
constexpr int NCLS = 24, CAP = R + 256;
constexpr int NCHUNK = R / 64;
constexpr float EPS = 1e-6f;
constexpr float LOG2E = 1.4426950408889634f;
constexpr float QSCALE = 0.125f * LOG2E;
constexpr float NEGBIG = -1e30f;

constexpr size_t MiB = 1u << 20;
constexpr size_t WS_CTL = 0, CTL_BYTES = 131072;
constexpr size_t WS_MOD = 1 * MiB;
constexpr size_t WS_SP8 = 2 * MiB;
constexpr size_t WS_GATEW = 3 * MiB;
constexpr size_t WS_WIN = 4 * MiB;
constexpr size_t WS_WOUT = 24 * MiB;
constexpr size_t WS_WUP = 32 * MiB;
constexpr size_t WS_WDN = 160 * MiB;
constexpr size_t WS_HB = 224 * MiB;
constexpr size_t WS_QKV = 290 * MiB;
constexpr size_t QKV_STRIDE = 33 * MiB;
constexpr size_t WS_XC = 455 * MiB;
constexpr size_t WS_AGG = 459 * MiB;
constexpr size_t WS_CARRY = 464 * MiB;
constexpr size_t WS_LIST = 467 * MiB;
constexpr size_t WS_WTL = 471 * MiB;
constexpr size_t WS_XB = 480 * MiB;
constexpr size_t WS_END = 546 * MiB;
static_assert((size_t)R * 512 * 2 <= QKV_STRIDE && (size_t)(R + NCLS * 256) * 2048 <= 5 * QKV_STRIDE, "ws map");
static_assert((size_t)NCLS * CAP * 4 <= 4 * MiB && (size_t)NCLS * CAP * 8 <= 7 * MiB, "ws map lists");
constexpr int CW_BAR = 1024;
constexpr int CW_CLS = 8192;
constexpr int CW_PAN = 12288;
constexpr int CW_CONV = 15616;
constexpr int CW_CARRY = 14848;
constexpr int CW_CDONE = 16192;
constexpr int CW_ECTX = 14336;
constexpr int CW_DONE = 16384;
constexpr int NCTX_IN = 40, NCTX_OUT = 16;

constexpr int LDS_BYTES = 147456;
constexpr int LDS_MISC = 131072;
constexpr int MISC_BAR = LDS_MISC + 320;
constexpr int MISC_GATE = LDS_MISC + 4096;
constexpr int MISC_CONV = LDS_MISC + 3072;
constexpr int MISC_CLS = LDS_MISC + 1024;

DI unsigned pk2(float lo, float hi) { f32x2 v = {lo, hi}; bf16x2_t b = __builtin_convertvector(v, bf16x2_t); return __builtin_bit_cast(unsigned, b); }
DI float bflo(unsigned w) { return __uint_as_float(w << 16); }
DI float bfhi(unsigned w) { return __uint_as_float(w & 0xffff0000u); }
DI void unpack8(const u32x4 w, f32x4& a, f32x4& b) { a = (f32x4){bflo(w.x), bfhi(w.x), bflo(w.y), bfhi(w.y)}; b = (f32x4){bflo(w.z), bfhi(w.z), bflo(w.w), bfhi(w.w)}; }
DI u32x4 pack8(const f32x4 a, const f32x4 b) { u32x4 w; w.x = pk2(a.x, a.y); w.y = pk2(a.z, a.w); w.z = pk2(b.x, b.y); w.w = pk2(b.z, b.w); return w; }
DI float shflx(float v, int o, int lane) { return __int_as_float(__builtin_amdgcn_ds_bpermute((lane ^ o) << 2, __float_as_int(v))); }
DI float wave_sum(float v, int lane) {
#pragma unroll
    for (int o = 1; o < 64; o <<= 1) v += shflx(v, o, lane);
    return v;
}
DI float fexp2(float x) { return __builtin_amdgcn_exp2f(x); }
DI float frcp(float x) { return __builtin_amdgcn_rcpf(x); }
DI float sigmoidf_(float x) { return frcp(1.0f + fexp2(-LOG2E * x)); }
DI float gelu_tanh(float x) { const float u = 0.7978845608028654f * (x + 0.044715f * x * x * x); return x * frcp(1.0f + fexp2(-2.0f * LOG2E * u)); }
#define LDS_WAIT() asm volatile("s_waitcnt lgkmcnt(0)" ::: "memory")
DI void st_wt_b32(void* p, float v) { asm volatile("global_store_dword %0, %1, off sc1" :: "v"(p), "v"(v) : "memory"); }
DI void st_wt_b64(void* p, u32x2 v) { asm volatile("global_store_dwordx2 %0, %1, off sc1" :: "v"(p), "v"(v) : "memory"); }

#define XB_TMO      128
#define XB_XCNT(j)  (256  + 64 * (j))
#define XB_XSUB(j)  (1280 + 64 * (j))
#define XB_XGEN(j)  (2304 + 64 * (j))
#define XB_TOP      3328
#define XB_TOPGEN   3392
#define XCD_BAR_WORDS 3456
#define XB_SPIN_CAP (1u << 18)
DI unsigned xb_ld(unsigned* p)              { return __hip_atomic_load(p, __ATOMIC_RELAXED, __HIP_MEMORY_SCOPE_AGENT); }
DI unsigned xb_add(unsigned* p, unsigned v) { return __hip_atomic_fetch_add(p, v, __ATOMIC_RELAXED, __HIP_MEMORY_SCOPE_AGENT); }
DI unsigned xb_xcc_id() { return (unsigned)__builtin_amdgcn_s_getreg((3 << 11) | 20) & 0xFu; }
#define XB_SPIN(cond, bar) do { unsigned _sp = 0; while (cond) { __builtin_amdgcn_s_sleep(1); \
    if ((++_sp & 255u) == 0u) { if (xb_ld(&(bar)[XB_TMO])) break; if (_sp > XB_SPIN_CAP) { atomicAdd(&(bar)[XB_TMO], 1u); break; } } } } while (0)
struct XcdBarrier { unsigned* bar; unsigned x; volatile LAS unsigned* st; };
DI XcdBarrier xcd_barrier_post(unsigned* bar, volatile LAS unsigned* st) {
    XcdBarrier b; b.bar = bar; b.x = xb_xcc_id(); b.st = st;
    if (threadIdx.x == 0) (void)xb_add(&bar[XB_XCNT(b.x)], 1u);
    return b;
}
DI void xcd_barrier_complete(unsigned* bar, unsigned x, unsigned& nloc, unsigned& nx) {
    const unsigned G = gridDim.x * gridDim.y * gridDim.z;
    unsigned sum, cnt, mine, sp = 0u;
    for (;;) {
        sum = 0u; cnt = 0u; mine = 0u;
#pragma unroll
        for (unsigned j = 0; j < 16; ++j) { const unsigned c = xb_ld(&bar[XB_XCNT(j)]); sum += c; cnt += (c > 0u) ? 1u : 0u; mine = (j == x) ? c : mine; }
        if (sum == G) break;
        __builtin_amdgcn_s_sleep(1);
        if ((++sp & 255u) == 0u) { if (xb_ld(&bar[XB_TMO])) break; if (sp > XB_SPIN_CAP) { atomicAdd(&bar[XB_TMO], 1u); break; } }
    }
    nloc = mine > 0u ? mine : 1u; nx = cnt > 0u ? cnt : 1u;
}
DI void xcd_barrier(const XcdBarrier& b) {
    asm volatile("s_waitcnt vmcnt(0)" ::: "memory");
    __syncthreads();
    if (threadIdx.x == 0) {
        unsigned* bar = b.bar;
        __builtin_amdgcn_s_waitcnt(0);
        unsigned nloc = b.st[0], nx = b.st[1];
        if (nloc == 0u) { xcd_barrier_complete(bar, b.x, nloc, nx); b.st[0] = nloc; b.st[1] = nx; }
        const unsigned old = xb_add(&bar[XB_XSUB(b.x)], 1u);
        const unsigned gen = old / nloc;
        if (old + 1u == (gen + 1u) * nloc) {
            __builtin_amdgcn_fence(__ATOMIC_RELEASE, "agent");
            asm volatile("s_waitcnt vmcnt(0)" ::: "memory");
            const unsigned og = xb_add(&bar[XB_TOP], 1u);
            const unsigned tg = og / nx;
            if (og + 1u == (tg + 1u) * nx) xb_add(&bar[XB_TOPGEN], 1u);
            else XB_SPIN(xb_ld(&bar[XB_TOPGEN]) == tg, bar);
            __builtin_amdgcn_fence(__ATOMIC_ACQUIRE, "agent");
            xb_add(&bar[XB_XGEN(b.x)], 1u);
            asm volatile("s_waitcnt vmcnt(0)" ::: "memory");
        } else {
            XB_SPIN(xb_ld(&bar[XB_XGEN(b.x)]) == gen, bar);
            __builtin_amdgcn_fence(__ATOMIC_ACQUIRE, "agent");
            asm volatile("s_waitcnt vmcnt(0)" ::: "memory");
        }
    }
    __syncthreads();
}

DI void xcd_barrier_arrive(const XcdBarrier& b) {
    asm volatile("s_waitcnt vmcnt(0)" ::: "memory");
    __syncthreads();
    if (threadIdx.x == 0) {
        unsigned* bar = b.bar;
        __builtin_amdgcn_s_waitcnt(0);
        unsigned nloc = b.st[0], nx = b.st[1];
        if (nloc == 0u) { xcd_barrier_complete(bar, b.x, nloc, nx); b.st[0] = nloc; b.st[1] = nx; }
        const unsigned old = xb_add(&bar[XB_XSUB(b.x)], 1u);
        const unsigned gen = old / nloc;
        if (old + 1u == (gen + 1u) * nloc) {
            __builtin_amdgcn_fence(__ATOMIC_RELEASE, "agent");
            asm volatile("s_waitcnt vmcnt(0)" ::: "memory");
            const unsigned og = xb_add(&bar[XB_TOP], 1u);
            const unsigned tg = og / nx;
            if (og + 1u == (tg + 1u) * nx) xb_add(&bar[XB_TOPGEN], 1u);
            else XB_SPIN(xb_ld(&bar[XB_TOPGEN]) == tg, bar);
            __builtin_amdgcn_fence(__ATOMIC_ACQUIRE, "agent");
            xb_add(&bar[XB_XGEN(b.x)], 1u);
            asm volatile("s_waitcnt vmcnt(0)" ::: "memory");
            b.st[2] = 0xffffffffu;
        } else b.st[2] = gen;
    }
    __syncthreads();
}
DI void xcd_barrier_wait(const XcdBarrier& b) {
    asm volatile("s_waitcnt vmcnt(0)" ::: "memory");
    __syncthreads();
    if (threadIdx.x == 0) {
        unsigned* bar = b.bar;
        const unsigned gen = b.st[2];
        if (gen != 0xffffffffu) {
            XB_SPIN(xb_ld(&bar[XB_XGEN(b.x)]) == gen, bar);
            __builtin_amdgcn_fence(__ATOMIC_ACQUIRE, "agent");
            asm volatile("s_waitcnt vmcnt(0)" ::: "memory");
        }
    }
    __syncthreads();
}

DI void panel_sync(unsigned* cnt, unsigned expect, unsigned* tmo) {
    asm volatile("s_waitcnt vmcnt(0)" ::: "memory");
    __syncthreads();
    if (threadIdx.x == 0) {
        __builtin_amdgcn_fence(__ATOMIC_RELEASE, "agent");
        asm volatile("s_waitcnt vmcnt(0)" ::: "memory");
        (void)__hip_atomic_fetch_add(cnt, 1u, __ATOMIC_RELAXED, __HIP_MEMORY_SCOPE_AGENT);
        unsigned sp = 0;
        while (__hip_atomic_load(cnt, __ATOMIC_RELAXED, __HIP_MEMORY_SCOPE_AGENT) < expect) { __builtin_amdgcn_s_sleep(2); if (++sp > (1u << 22)) { atomicAdd(tmo, 1u); break; } }
        __builtin_amdgcn_fence(__ATOMIC_ACQUIRE, "agent");
        asm volatile("s_waitcnt vmcnt(0)" ::: "memory");
    }
    __syncthreads();
}

DI void wait_count(unsigned* cnt, unsigned expect, unsigned* tmo) {
    if (threadIdx.x == 0) {
        unsigned sp = 0;
        while (__hip_atomic_load(cnt, __ATOMIC_RELAXED, __HIP_MEMORY_SCOPE_AGENT) < expect) { __builtin_amdgcn_s_sleep(2); if (++sp > (1u << 22)) { atomicAdd(tmo, 1u); break; } }
        __builtin_amdgcn_fence(__ATOMIC_ACQUIRE, "agent");
        asm volatile("s_waitcnt vmcnt(0)" ::: "memory");
    }
    asm volatile("" ::: "memory"); __builtin_amdgcn_s_barrier(); asm volatile("" ::: "memory");
}

constexpr int MISC_TP = LDS_MISC + 2048, CW_TP = 16256;
DI unsigned tp_now() { return (unsigned)__builtin_amdgcn_s_memrealtime(); }
#define TP_BEGIN(id, var) unsigned var = 0u; if (TPROF == (id)) { if (threadIdx.x < 64) var = tp_now(); }
#define TP_END(id, var, L) do { if (TPROF == (id)) { if (threadIdx.x < 64) { const unsigned dt_ = tp_now() - var; if (threadIdx.x == 0) *(LAS unsigned*)((L) + MISC_TP) += dt_; } } } while (0)
struct Args { const float* in[25]; float* out; unsigned char* ws; int ph_lo, ph_hi; };
struct Base { LAS unsigned char* lds; int tid, lane, wave, bid, G; };
struct Ctx {
    LAS unsigned char* lds;
    int tid, lane, wave, bid, G;
    const float *x, *c, *ctx, *c_ctx, *w_mod, *b_mod, *norm_mix, *norm_ffn, *w_in, *w_out, *q_gain, *k_gain, *na_bias, *conv_w, *conv_b,
                *lru_w_r, *lru_b_r, *lru_w_i, *lru_b_i, *lru_lambda, *router_w, *router_b, *exp_w1, *exp_w3, *exp_w2;
    float* out;
    unsigned* ctl; float* mod; float* sp8; bf16_t* gatew; bf16_t* win; bf16_t* wout; bf16_t* wup; bf16_t* wdn;
    bf16_t* hb; bf16_t* qkv; bf16_t* hid; float* xc; f32x2* agg; float* carry; int* list; f32x2* wtl; bf16_t* xb;
};
typedef const __attribute__((address_space(4))) Args* KArgsP;
DI Ctx make_ctx(const Base& B) {
    auto kp = __builtin_amdgcn_kernarg_segment_ptr();
    asm volatile("" : "+s"(kp));
    KArgsP a = (KArgsP)kp;
    Ctx X;
    int tid_ = B.tid, bid_ = B.bid, g_ = B.G;
    asm volatile("" : "+v"(tid_)); asm volatile("" : "+s"(bid_), "+s"(g_));
    X.lds = B.lds; X.tid = tid_; X.lane = tid_ & 63; X.wave = __builtin_amdgcn_readfirstlane(tid_ >> 6); X.bid = bid_; X.G = g_;
    X.x = a->in[0]; X.c = a->in[1]; X.ctx = a->in[2]; X.c_ctx = a->in[3]; X.w_mod = a->in[4]; X.b_mod = a->in[5]; X.norm_mix = a->in[6]; X.norm_ffn = a->in[7];
    X.w_in = a->in[8]; X.w_out = a->in[9]; X.q_gain = a->in[10]; X.k_gain = a->in[11]; X.na_bias = a->in[12]; X.conv_w = a->in[13]; X.conv_b = a->in[14];
    X.lru_w_r = a->in[15]; X.lru_b_r = a->in[16]; X.lru_w_i = a->in[17]; X.lru_b_i = a->in[18]; X.lru_lambda = a->in[19]; X.router_w = a->in[20]; X.router_b = a->in[21];
    X.exp_w1 = a->in[22]; X.exp_w3 = a->in[23]; X.exp_w2 = a->in[24]; X.out = a->out;
    unsigned char* ws = a->ws;
    X.ctl = (unsigned*)(ws + WS_CTL); X.mod = (float*)(ws + WS_MOD); X.sp8 = (float*)(ws + WS_SP8); X.gatew = (bf16_t*)(ws + WS_GATEW);
    X.win = (bf16_t*)(ws + WS_WIN); X.wout = (bf16_t*)(ws + WS_WOUT); X.wup = (bf16_t*)(ws + WS_WUP); X.wdn = (bf16_t*)(ws + WS_WDN);
    X.hb = (bf16_t*)(ws + WS_HB); X.qkv = (bf16_t*)(ws + WS_QKV); X.hid = (bf16_t*)(ws + WS_QKV); X.xc = (float*)(ws + WS_XC);
    X.agg = (f32x2*)(ws + WS_AGG); X.carry = (float*)(ws + WS_CARRY); X.list = (int*)(ws + WS_LIST); X.wtl = (f32x2*)(ws + WS_WTL); X.xb = (bf16_t*)(ws + WS_XB);
    return X;
}
typedef _Float16 h16x2 __attribute__((ext_vector_type(2)));
DI u32x2* ab_ptr(const Ctx& X, int row, int dir) { return row < RL ? (u32x2*)X.out + ((size_t)(row >> 1) * 2 + dir) * 512 : (u32x2*)X.xc + ((size_t)((row - RL) >> 1) * 2 + dir) * 512; }
DI int row_mb(int row) { return row < RL ? (row >> 13) : 4; }

DI void p0_transpose_item(const float* W, int K, int N, bf16_t* WT, LAS float* scr, int kb, int nb, int lane) {
    const int k0 = 64 * kb, n0 = 64 * nb, n4 = 4 * (lane & 15), kq = lane >> 4;
    f32x4 v[16];
#pragma unroll
    for (int i = 0; i < 16; ++i) v[i] = __builtin_nontemporal_load((const f32x4*)(W + (size_t)(k0 + 4 * i + kq) * N + n0 + n4));
#pragma unroll
    for (int i = 0; i < 16; ++i) { const int k = 4 * i + kq; *(LAS f32x4*)(scr + k * 64 + (n4 ^ (((k >> 3) & 7) << 2))) = v[i]; }
    LDS_WAIT(); asm volatile("" ::: "memory");
    const int kc = lane & 7, nl = lane >> 3;
#pragma unroll
    for (int j = 0; j < 8; ++j) { const int n = nl + 8 * j; const LAS float* sp = scr + (8 * kc) * 64 + (n ^ (kc << 2));
        u32x4 o; o.x = pk2(sp[0 * 64], sp[1 * 64]); o.y = pk2(sp[2 * 64], sp[3 * 64]); o.z = pk2(sp[4 * 64], sp[5 * 64]); o.w = pk2(sp[6 * 64], sp[7 * 64]);
        *(u32x4*)(WT + (size_t)(n0 + n) * K + k0 + 8 * kc) = o; }
    LDS_WAIT(); asm volatile("" ::: "memory");
}
constexpr int L_ITEMS = 640 + 256 + 4096 + 2048;
DI void conv_item(const Ctx& X, int l, int r, LAS float* scr, int lane) {
    const float* W; bf16_t* WT; int K, N, kb, nb;
    if (r < 640) { W = X.w_in + (size_t)l * 1024 * NIN; K = 1024; N = NIN; WT = X.win + (size_t)l * NIN * 1024; kb = r / 40; nb = r % 40; }
    else if ((r -= 640) < 256) { W = X.w_out + (size_t)l * 1024 * 1024; K = 1024; N = 1024; WT = X.wout + (size_t)l * 1024 * 1024; kb = r / 16; nb = r % 16; }
    else if ((r -= 256) < 4096) { const int e = r >> 8; int q = r & 255; const int which = q >> 7; q &= 127;
        W = (which ? X.exp_w3 : X.exp_w1) + (size_t)(l * 16 + e) * 1024 * 512; K = 1024; N = 512; WT = X.wup + ((size_t)(l * 16 + e) * 1024 + which * 512) * 1024; kb = q / 8; nb = q % 8; }
    else { r -= 4096; const int e = r >> 7, q = r & 127; W = X.exp_w2 + (size_t)(l * 16 + e) * 512 * 1024; K = 512; N = 1024; WT = X.wdn + (size_t)(l * 16 + e) * 1024 * 512; kb = q / 16; nb = q % 16; }
    p0_transpose_item(W, K, N, WT, scr, kb, nb, lane);
}
DI void phase_p0(const Base& B, int part) {
    const Ctx X = make_ctx(B);
    if (part == 0) {
    LAS float* silu_c = (LAS float*)(X.lds);
    LAS float* red = (LAS float*)(X.lds + 32768);
    { float cvv[10];
#pragma unroll
      for (int q = 0; q < 10; ++q) { const int i = X.tid + 512 * q, v = i >> 10, k = i & 1023; const float* p = v < 4 ? X.c + v * 1024 + k : X.c_ctx + k; cvv[q] = *p; }
#pragma unroll
      for (int q = 0; q < 10; ++q) silu_c[X.tid + 512 * q] = cvv[q] * frcp(1.0f + fexp2(-LOG2E * cvv[q])); }
    __syncthreads();
    for (int u = X.bid; u < DEPTH * 192; u += X.G) {
        const int l = u / 192, n0 = (u % 192) * 32, kg = X.tid >> 3, cq = X.tid & 7;
        f32x4 acc[5];
#pragma unroll
        for (int v = 0; v < 5; ++v) acc[v] = (f32x4){0.f, 0.f, 0.f, 0.f};
        const float* wp = X.w_mod + ((size_t)l * 1024 + kg * 16) * 6144 + n0 + 4 * cq;
#pragma unroll 8
        for (int k = 0; k < 16; ++k) { const f32x4 w = __builtin_nontemporal_load((const f32x4*)(wp + (size_t)k * 6144));
#pragma unroll
            for (int v = 0; v < 5; ++v) acc[v] += w * silu_c[v * 1024 + kg * 16 + k]; }
#pragma unroll
        for (int v = 0; v < 5; ++v) *(LAS f32x4*)(red + (kg * 5 + v) * 32 + 4 * cq) = acc[v];
        __syncthreads();
        if (X.tid < 160) { const int v = X.tid >> 5, col = X.tid & 31; float s = X.b_mod[l * 6144 + n0 + col];
#pragma unroll 8
            for (int g = 0; g < 64; ++g) s += red[(g * 5 + v) * 32 + col];
            X.mod[(size_t)(l * 5 + v) * 6144 + n0 + col] = s; }
        __syncthreads();
    }
    for (int i = X.bid * 512 + X.tid; i < DEPTH * 2 * 512; i += X.G * 512) X.sp8[i] = 8.0f * log1pf(__expf(-X.lru_lambda[i]));
    __syncthreads();
    { LAS float* scr0 = (LAS float*)(X.lds + X.wave * 16384);
      for (int it = X.bid * 8 + X.wave; it < 640; it += X.G * 8) conv_item(X, 0, it, scr0, X.lane); }
    __syncthreads();
    return; }
    LAS float* scr = (LAS float*)(X.lds + X.wave * 16384);
    const int gw = X.bid * 8 + X.wave, NGW = X.G * 8;
    for (int it = gw; it < L_ITEMS + 128; it += NGW) {
        if (it < L_ITEMS) { if (it >= 640) conv_item(X, 0, it, scr, X.lane); }
        else { const int mi = it - L_ITEMS; const int gate = (mi >> 3) & 1, ld = mi >> 4, blk = mi & 7;
            p0_transpose_item((gate ? X.lru_w_i : X.lru_w_r) + (size_t)(ld * 8 + blk) * 4096, 64, 64, X.gatew + (size_t)mi * 4096, scr, 0, 0, X.lane); }
    }
}
DI void phase_conv(const Base& B, int l) {
    const Ctx X = make_ctx(B);
    LAS float* scr = (LAS float*)(X.lds + X.wave * 16384);
    LAS int* slot = (LAS int*)(X.lds + MISC_CONV);
    const int x = X.bid & 7;
    unsigned* head = X.ctl + CW_CONV + (l * 8 + x) * 16;
    constexpr int NSH = L_ITEMS / 8, WCH = 8, NCH = NSH / WCH;
    static_assert(L_ITEMS % 8 == 0 && NSH % WCH == 0, "chunking");
    if (X.tid == 0) slot[0] = (int)__hip_atomic_fetch_add(head, 1u, __ATOMIC_RELAXED, __HIP_MEMORY_SCOPE_AGENT);
    __syncthreads();
    int c = slot[0], par = 0;
    while (c < NCH) {
        int nv = 0;
        if (X.tid == 0) nv = (int)__hip_atomic_fetch_add(head, 1u, __ATOMIC_RELAXED, __HIP_MEMORY_SCOPE_AGENT);
        { const int r_ = x * NSH + c * WCH + X.wave; if (r_ >= 640) conv_item(X, l, r_, scr, X.lane); }
        if (X.tid == 0) slot[par ^ 1] = nv;
        __syncthreads();
        par ^= 1; c = slot[par];
    }
    __syncthreads();
}

DI void conv_in(const Base& B, int l) {
    const Ctx X = make_ctx(B);
    LAS float* scr = (LAS float*)(X.lds + X.wave * 16384);
    for (int it = X.bid * 8 + X.wave; it < 640; it += X.G * 8) conv_item(X, l, it, scr, X.lane);
    __syncthreads();
}

template <bool BF> DI void norm1_rows(const Ctx& X, int l, int r0, int r1, int rs) {
    const int lane = X.lane;
#define CIX(j) (BF ? 8 * lane + 512 * ((j) >> 1) + 4 * ((j) & 1) : 4 * lane + 256 * (j))
#define XROWF(row) ((row) < RL ? X.x + (size_t)(row) * D : X.ctx + (size_t)((row) - RL) * D)
    f32x4 gn4[4], sc4[4], sh4[4], nv[4]; u32x4 nw[2]; int cmb = -1;
#pragma unroll
    for (int j = 0; j < 4; ++j) gn4[j] = *(const f32x4*)(X.norm_mix + l * D + CIX(j));
    if (r0 < r1) {
        if (BF) { nw[0] = *(const u32x4*)(X.xb + (size_t)r0 * D + 8 * lane); nw[1] = *(const u32x4*)(X.xb + (size_t)r0 * D + 512 + 8 * lane); }
        else {
#pragma unroll
            for (int j = 0; j < 4; ++j) nv[j] = *(const f32x4*)(XROWF(r0) + CIX(j)); } }
    for (int row = r0; row < r1; row += rs) {
        f32x4 v[4];
        if (BF) { unpack8(nw[0], v[0], v[1]); unpack8(nw[1], v[2], v[3]); }
        else {
#pragma unroll
            for (int j = 0; j < 4; ++j) v[j] = nv[j]; }
        if (row + rs < r1) {
            if (BF) { nw[0] = *(const u32x4*)(X.xb + (size_t)(row + rs) * D + 8 * lane); nw[1] = *(const u32x4*)(X.xb + (size_t)(row + rs) * D + 512 + 8 * lane); }
            else {
#pragma unroll
                for (int j = 0; j < 4; ++j) nv[j] = *(const f32x4*)(XROWF(row + rs) + CIX(j)); } }
        const int mb = row_mb(row);
        if (mb != cmb) { cmb = mb; const float* sh = X.mod + (size_t)((l * 5 + mb) * 6 + 0) * 1024;
#pragma unroll
            for (int j = 0; j < 4; ++j) { sh4[j] = *(const f32x4*)(sh + CIX(j)); sc4[j] = *(const f32x4*)(sh + 1024 + CIX(j)) + 1.0f; } }
        float s = 0.f;
#pragma unroll
        for (int j = 0; j < 4; ++j) s += (v[j].x * v[j].x + v[j].y * v[j].y) + (v[j].z * v[j].z + v[j].w * v[j].w);
        const float rsd = __builtin_amdgcn_rsqf(wave_sum(s, lane) * (1.0f / D) + EPS);
        bf16_t* o = X.hb + (size_t)row * D;
#pragma unroll
        for (int j = 0; j < 4; ++j) { const f32x4 y = v[j] * rsd * gn4[j] * sc4[j] + sh4[j];
            u32x2 w; w.x = pk2(y.x, y.y); w.y = pk2(y.z, y.w); *(u32x2*)(o + CIX(j)) = w; }
    }
#undef CIX
#undef XROWF
}
DI bool phase_norm1(const Base& B, int l) {
    const Ctx X = make_ctx(B);
    const int nlat = X.G - NCTX_IN;
    const bool isctx = X.bid >= nlat;
    const int j = X.bid - nlat, p = j / 10, q = j % 10;
    const int r0 = isctx ? RL + 256 * p + 26 * q + X.wave : X.bid * 8 + X.wave;
    const int r1 = isctx ? (q == 9 ? RL + 256 * p + 256 : RL + 256 * p + 26 * q + 26) : RL;
    if (l == 0) norm1_rows<false>(X, l, r0, r1, isctx ? 8 : nlat * 8); else norm1_rows<true>(X, l, r0, r1, isctx ? 8 : nlat * 8);
    if (isctx) panel_sync(X.ctl + CW_PAN + (l * 4 + p) * 64, 10u, X.ctl + CW_BAR + XB_TMO);
    return isctx;
}

constexpr int BK = 64, HALF = 128, HTB = HALF * BK * 2;
DI int lds_byte(int r, int c) { return r * 128 + ((((c >> 3) ^ r) & 7) << 4) + (c & 7) * 2; }
DI void stage_rc(int b, int& Rr, int& Cc) { Rr = b >> 7; Cc = ((((b >> 4) ^ Rr) & 7)) * 8; }
DI int perm32(int rho) { const int n = rho >> 4, i = rho & 15; return 8 * (i >> 2) + 4 * n + (i & 3); }

enum { K_IN = 0, K_OUT = 1, K_UP = 2, K_DOWN = 3 };
struct GU { const char* a; const char* b; const char* bh; int i0, i1, i2, i3; };
template <int KIND> struct GK {
    static constexpr size_t A_HSTEP = KIND == K_UP ? 0 : (size_t)128 * 2048;
    static constexpr size_t B_HSTEP = KIND == K_IN ? (size_t)32 * 2048 : (KIND == K_OUT ? (size_t)128 * 2048 : (KIND == K_UP ? (size_t)512 * 2048 : (size_t)128 * 1024));
    static constexpr int KS = KIND == K_DOWN ? 8 : 16;
};

DI void cls_tables(const Ctx& X, int l) {
    LAS int* ct = (LAS int*)(X.lds + MISC_CLS);
    if (X.tid < NCLS) ct[X.tid] = (int)__hip_atomic_load(X.ctl + CW_CLS + l * 32 + X.tid, __ATOMIC_RELAXED, __HIP_MEMORY_SCOPE_AGENT);
    __syncthreads();
    if (X.tid == 0) { int tb = 0;
        for (int c = 0; c < NCLS; ++c) { ct[32 + c] = tb; tb += (ct[c] + 255) >> 8; }
        ct[32 + NCLS] = tb; }
    __syncthreads();
    if (X.tid < 160) { int c = 0; while (c < NCLS - 1 && X.tid >= ct[32 + c + 1]) ++c; ct[64 + X.tid] = c; }
    __syncthreads();
}
DI int cls_of_tile(const LAS int* ct, int T) { return ct[64 + (T < 160 ? T : 159)]; }
DI void cls_experts(int c, int& elo, int& ehi) { const int g = c / 6, p = c % 6; const int lo = p < 3 ? 0 : (p < 5 ? 1 : 2); const int hi = p < 3 ? p + 1 : (p < 5 ? p - 1 : 3); elo = 4 * g + lo; ehi = 4 * g + hi; }

template <int KIND> DI bool gemm_unit(const Ctx& X, int l, int idx, GU& u, int mode) {
    const bool xo = (X.G == 256);
    const int x = X.bid & 7, j = idx * 32 + (X.bid >> 3);
    int un = idx * X.G + X.bid;
    if (KIND == K_IN) {
        int pm, pn;
        if (mode) { if (idx > 0) return false; un = (RL / 256) * 10 + X.bid - (X.G - NCTX_IN); pm = un / 10; pn = un % 10; }
        else if (xo) { if (j >= 160) return false;
            if (j < 128) { const int g = j >> 5, jj = j & 31; pm = 16 * x + 8 * (g & 1) + (jj >> 2); pn = 4 * (g >> 1) + (jj & 3); }
            else { const int jj = j - 128; pm = 16 * x + (jj >> 1); pn = 8 + (jj & 1); } }
        else { if (un >= (RL / 256) * 10) return false; pm = un / 10; pn = un % 10; }
        u.a = (const char*)X.hb + (size_t)pm * 256 * 2048;
        u.b = (const char*)X.win + ((size_t)l * NIN + 256 * pn) * 2048; u.bh = u.b;
        u.i0 = pm; u.i1 = pn; u.i2 = 0; u.i3 = 0; return true;
    } else if (KIND == K_OUT) {
        int pm, pn;
        if (mode) { if (idx > 0) return false; un = (RL / 256) * 4 + X.bid - (X.G - NCTX_OUT); pm = un / 4; pn = un % 4; }
        else if (xo) { if (j >= 64) return false; pm = 16 * x + 8 * (j >> 5) + ((j & 31) >> 2); pn = j & 3; }
        else { if (un >= (RL / 256) * 4) return false; pm = un / 4; pn = un % 4; }
        u.a = (const char*)X.hb + (size_t)pm * 256 * 2048;
        u.b = (const char*)X.wout + ((size_t)l * 1024 + 256 * pn) * 2048; u.bh = u.b;
        u.i0 = pm; u.i1 = pn; u.i2 = 0; u.i3 = 0; return true;
    } else if (KIND == K_UP) {
        const LAS int* ct = (const LAS int*)(X.lds + MISC_CLS);
        const int NT = ct[32 + NCLS];
        int T, pn;
        if (xo) { if (j >= NT) return false; const int g = x * NT + j; T = g >> 3; pn = g & 7; }
        else { if (un >= NT * 8) return false; T = un >> 3; pn = un & 7; }
        const int c = cls_of_tile(ct, T); int elo, ehi; cls_experts(c, elo, ehi);
        const int e = pn < 4 ? elo : ehi, pnl = pn & 3;
        u.a = (const char*)X.hb;
        u.b = (const char*)X.wup + ((size_t)(l * 16 + e) * 1024 + 128 * pnl) * 2048; u.bh = u.b;
        u.i0 = T; u.i1 = pn; u.i2 = c; u.i3 = (T - ct[32 + c]) * 256; return true;
    } else {
        const LAS int* ct = (const LAS int*)(X.lds + MISC_CLS);
        const int NT = ct[32 + NCLS];
        int T, pn;
        if (xo) { const int d0 = (x * NT) >> 1, nd = (((x + 1) * NT) >> 1) - d0, jr = idx * 32 + 31 - (X.bid >> 3);
            if (jr >= nd) return false;
            int loc = jr + 4; if (loc >= nd) loc -= nd;
            const int g = d0 + loc; T = g >> 2; pn = g & 3; }
        else { if (un >= NT * 4) return false; T = un >> 2; pn = un & 3; }
        const int c = cls_of_tile(ct, T); int elo, ehi; cls_experts(c, elo, ehi);
        u.a = (const char*)X.hid + (size_t)T * 256 * 2048;
        u.b = (const char*)X.wdn + ((size_t)(l * 16 + elo) * 1024 + 256 * pn) * 1024;
        u.bh = (const char*)X.wdn + ((size_t)(l * 16 + ehi) * 1024 + 256 * pn) * 1024 - 8 * 128;
        u.i0 = T; u.i1 = pn; u.i2 = c; u.i3 = (T - ct[32 + c]) * 256; return true;
    }
}
DI void gather_voffA(const Ctx& X, const GU& u, const int (&Rr)[2], const int (&Cc)[2], unsigned (&vo)[2][2]) {
    const LAS int* ct = (const LAS int*)(X.lds + MISC_CLS);
    const int cnt = ct[u.i2];
    int tk[2][2];
#pragma unroll
    for (int h = 0; h < 2; ++h)
#pragma unroll
        for (int i = 0; i < 2; ++i) { const int pos = u.i3 + 128 * h + Rr[i]; tk[h][i] = X.list[(size_t)u.i2 * CAP + (pos < cnt ? pos : 0)]; }
#pragma unroll
    for (int h = 0; h < 2; ++h)
#pragma unroll
        for (int i = 0; i < 2; ++i) { const int pos = u.i3 + 128 * h + Rr[i]; const int tok = pos < cnt ? tk[h][i] : 0; vo[h][i] = (unsigned)(tok * 1024 + Cc[i]) * 2u; }
}

template <int KIND> DI void gemm_epilogue(const Ctx& X, int l, const f32x4 (&acc)[2][2][4][2], const GU& u, int wr, int wc, int fr, int fq, int par) {
    if (KIND == K_IN) {
        const int pm = u.i0, pn = u.i1, buf = pn >> 1;
        bf16_t* O = X.qkv + (size_t)buf * (QKV_STRIDE / 2);
        const int colb = 256 * (pn & 1) + 64 * wc + 8 * fq;
        if (buf < 2) {
            const float* gp = (buf == 0 ? X.q_gain : X.k_gain) + l * 64; const float scl = buf == 0 ? QSCALE : 1.0f;
            f32x4 gv[2][2];
#pragma unroll
            for (int bj = 0; bj < 2; ++bj)
#pragma unroll
                for (int n = 0; n < 2; ++n) gv[bj][n] = *(const f32x4*)(gp + 32 * bj + 8 * fq + 4 * n) * scl;
#pragma unroll
            for (int ai = 0; ai < 2; ++ai)
#pragma unroll
                for (int m = 0; m < 4; ++m) {
                    float ss = 0.f;
#pragma unroll
                    for (int bj = 0; bj < 2; ++bj)
#pragma unroll
                        for (int n = 0; n < 2; ++n) { const f32x4 v = acc[ai][bj][m][n]; ss += (v.x * v.x + v.y * v.y) + (v.z * v.z + v.w * v.w); }
                    ss += shflx(ss, 16, X.lane); ss += shflx(ss, 32, X.lane);
                    const float rs = __builtin_amdgcn_rsqf(ss * (1.0f / 64.0f) + EPS);
                    bf16_t* rowp = O + (size_t)(pm * 256 + ai * 128 + wr * 64 + m * 16 + fr) * 512 + colb;
#pragma unroll
                    for (int bj = 0; bj < 2; ++bj) { const f32x4 v0 = acc[ai][bj][m][0] * gv[bj][0] * rs, v1 = acc[ai][bj][m][1] * gv[bj][1] * rs;
                        u32x4 w; w.x = pk2(v0.x, v0.y); w.y = pk2(v0.z, v0.w); w.z = pk2(v1.x, v1.y); w.w = pk2(v1.z, v1.w); *(u32x4*)(rowp + 32 * bj) = w; }
                }
        } else {
#pragma unroll
            for (int ai = 0; ai < 2; ++ai)
#pragma unroll
                for (int m = 0; m < 4; ++m) {
                    bf16_t* rowp = O + (size_t)(pm * 256 + ai * 128 + wr * 64 + m * 16 + fr) * 512 + colb;
#pragma unroll
                    for (int bj = 0; bj < 2; ++bj) { const f32x4 v0 = acc[ai][bj][m][0], v1 = acc[ai][bj][m][1];
                        u32x4 w; w.x = pk2(v0.x, v0.y); w.y = pk2(v0.z, v0.w); w.z = pk2(v1.x, v1.y); w.w = pk2(v1.z, v1.w); *(u32x4*)(rowp + 32 * bj) = w; }
                }
        }
    } else if (KIND == K_OUT) {
        const int pm = u.i0, pn = u.i1, row0 = pm * 256;
        const float* xin = row0 < RL ? X.x + (size_t)row0 * D : X.ctx + (size_t)(row0 - RL) * D;
        bf16_t* xo = X.xb + (size_t)row0 * D;
        const __amdgpu_buffer_rsrc_t xrs = __builtin_amdgcn_make_buffer_rsrc((void*)X.xb, 0, (int)((size_t)R * 2048), 0x00020000);
        const int col0 = 256 * pn + 32 * wc + 8 * fq;
        const LAS float* gl = (const LAS float*)(X.lds + MISC_GATE + par * 1024) + 32 * wc + 8 * fq;
#define G_GV(bj, n) (*(const LAS f32x4*)(gl + 128 * (bj) + 4 * (n)))
        if (l == 0) {
#pragma unroll
            for (int ai = 0; ai < 2; ++ai)
#pragma unroll
                for (int m = 0; m < 4; ++m) { const size_t ro = (size_t)(ai * 128 + wr * 64 + m * 16 + fr) * D + col0;
                    const f32x4 xa0 = *(const f32x4*)(xin + ro), xa1 = *(const f32x4*)(xin + ro + 4), xb0 = *(const f32x4*)(xin + ro + 128), xb1 = *(const f32x4*)(xin + ro + 132);
                    *(u32x4*)(xo + ro) = pack8(xa0 + G_GV(0, 0) * acc[ai][0][m][0], xa1 + G_GV(0, 1) * acc[ai][0][m][1]);
                    *(u32x4*)(xo + ro + 128) = pack8(xb0 + G_GV(1, 0) * acc[ai][1][m][0], xb1 + G_GV(1, 1) * acc[ai][1][m][1]); }
        } else {
#pragma unroll
            for (int ai = 0; ai < 2; ++ai) { u32x4 ob[4][2];
#pragma unroll
                for (int m = 0; m < 4; ++m)
#pragma unroll
                    for (int bj = 0; bj < 2; ++bj) ob[m][bj] = __builtin_amdgcn_raw_buffer_load_b128(xrs, (int)(((size_t)(row0 + ai * 128 + wr * 64 + m * 16 + fr) * D + col0 + 128 * bj) * 2), 0, 0);
                asm volatile("" ::: "memory");
#pragma unroll
                for (int m = 0; m < 4; ++m)
#pragma unroll
                    for (int bj = 0; bj < 2; ++bj) { f32x4 x0, x1; unpack8(ob[m][bj], x0, x1);
                        __builtin_amdgcn_raw_buffer_store_b128(pack8(x0 + G_GV(bj, 0) * acc[ai][bj][m][0], x1 + G_GV(bj, 1) * acc[ai][bj][m][1]), xrs, (int)(((size_t)(row0 + ai * 128 + wr * 64 + m * 16 + fr) * D + col0 + 128 * bj) * 2), 0, 0); } }
        }
#undef G_GV
    } else if (KIND == K_UP) {
        const int T = u.i0, pn = u.i1, c = u.i2, pos0 = u.i3, which = pn >> 2, pnl = pn & 3;
        const int col0 = 512 * which + 128 * pnl + 32 * wc + 8 * fq;
        const __amdgpu_buffer_rsrc_t hrs = __builtin_amdgcn_make_buffer_rsrc((void*)X.hid, 0, (int)((size_t)(R + NCLS * 256) * 2048), 0x00020000);
        float w2a[2][4];
#pragma unroll
        for (int ai = 0; ai < 2; ++ai)
#pragma unroll
            for (int m = 0; m < 4; ++m) w2a[ai][m] = ((const float*)(X.wtl + (size_t)c * CAP + pos0 + ai * 128 + wr * 64 + m * 16 + fr))[which];
#pragma unroll
        for (int ai = 0; ai < 2; ++ai)
#pragma unroll
            for (int m = 0; m < 4; ++m) { const int lr = ai * 128 + wr * 64 + m * 16 + fr;
                const float wt = w2a[ai][m];
                float o[8];
#pragma unroll
                for (int n = 0; n < 2; ++n)
#pragma unroll
                    for (int e = 0; e < 4; ++e) { const float a = acc[ai][0][m][n][e], b = acc[ai][1][m][n][e]; o[4 * n + e] = a * frcp(1.0f + fexp2(-LOG2E * a)) * b * wt; }
                u32x4 w; w.x = pk2(o[0], o[1]); w.y = pk2(o[2], o[3]); w.z = pk2(o[4], o[5]); w.w = pk2(o[6], o[7]);
                __builtin_amdgcn_raw_buffer_store_b128(w, hrs, (int)(((size_t)(T * 256 + lr) * 1024 + col0) * 2), 0, 16); }
    } else {
        const int pn = u.i1, c = u.i2, pos0 = u.i3;
        const LAS int* ct = (const LAS int*)(X.lds + MISC_CLS); const int cnt = ct[c];
        const int col0 = 256 * pn + 32 * wc + 8 * fq;
        const LAS unsigned char* gt = X.lds + MISC_GATE + 2048 + par * 5120 + (32 * wc + 8 * fq) * 4;
        int tok[2][4];
#pragma unroll
        for (int ai = 0; ai < 2; ++ai)
#pragma unroll
            for (int m = 0; m < 4; ++m) { const int pos = pos0 + ai * 128 + wr * 64 + m * 16 + fr; tok[ai][m] = pos < cnt ? X.list[(size_t)c * CAP + pos] : -1; }
#pragma unroll
        for (int ai = 0; ai < 2; ++ai) { u32x4 ob[4][2];
#pragma unroll
            for (int m = 0; m < 4; ++m) { const int tk = tok[ai][m] < 0 ? 0 : tok[ai][m]; const bf16_t* xi = X.xb + (size_t)tk * D + col0;
#pragma unroll
                for (int bj = 0; bj < 2; ++bj) ob[m][bj] = *(const u32x4*)(xi + 128 * bj); }
            asm volatile("" ::: "memory");
#pragma unroll
            for (int m = 0; m < 4; ++m) { const int tk = tok[ai][m];
                if (tk >= 0) { const LAS unsigned char* gm_ = gt + row_mb(tk) * 1024;
#pragma unroll
                    for (int bj = 0; bj < 2; ++bj) { f32x4 x0, x1; unpack8(ob[m][bj], x0, x1);
                        x0 += *(const LAS f32x4*)(gm_ + 512 * bj) * acc[ai][bj][m][0]; x1 += *(const LAS f32x4*)(gm_ + 512 * bj + 16) * acc[ai][bj][m][1];
                        if (l == DEPTH - 1) { float* of = X.out + (size_t)tk * D + col0 + 128 * bj; __builtin_nontemporal_store(x0, (f32x4*)of); __builtin_nontemporal_store(x1, (f32x4*)(of + 4)); }
                        else *(u32x4*)(X.xb + (size_t)tk * D + col0 + 128 * bj) = pack8(x0, x1); } } } }
    }
}

template <int KIND, bool ALIGN_EPI> DI void gemm_phase(const Base& B, int l, int mode) {
    const Ctx X = make_ctx(B);
    if (KIND == K_UP || (KIND == K_DOWN && MK_MULTI)) cls_tables(X, l);
    LAS unsigned char* lds = X.lds;
    const int tid = X.tid, wid = X.wave, lane = X.lane, wr = wid >> 2, wc = wid & 3, fr = lane & 15, fq = lane >> 4;
    constexpr int nt = 16, KS = GK<KIND>::KS;
    constexpr size_t kstep = 128, ahstep = GK<KIND>::A_HSTEP, bhstep = GK<KIND>::B_HSTEP;
    int Rr[2], Cc[2]; unsigned voffB[2], voc[2][2], von[2][2];
#pragma unroll
    for (int i = 0; i < 2; ++i) { stage_rc(tid * 16 + i * 8192, Rr[i], Cc[i]);
        if (KIND == K_IN) voffB[i] = (unsigned)((64 * (Rr[i] >> 5) + perm32(Rr[i] & 31)) * 1024 + Cc[i]) * 2u;
        else if (KIND == K_DOWN) voffB[i] = (unsigned)(((Rr[i] & ~31) + perm32(Rr[i] & 31)) * 512 + Cc[i]) * 2u;
        else voffB[i] = (unsigned)(((Rr[i] & ~31) + perm32(Rr[i] & 31)) * 1024 + Cc[i]) * 2u;
        voc[0][i] = voc[1][i] = von[0][i] = von[1][i] = (unsigned)(Rr[i] * 1024 + Cc[i]) * 2u; }
    const unsigned ldsw = (unsigned)wid * 1024u;
    const int aoff = lds_byte(wr * 64 + fr, fq * 8), boff = lds_byte(wc * 32 + fr, fq * 8), aoff1 = lds_byte(wr * 64 + fr, 32 + fq * 8), boff1 = lds_byte(wc * 32 + fr, 32 + fq * 8);
#define G_SA(b, h) (((b) * 2 + (h)) * HTB)
#define G_SB(b, h) ((4 + (b) * 2 + (h)) * HTB)
#define G_STAGE(bufoff, gbase, v0, v1) do { \
        __builtin_amdgcn_global_load_lds((const unsigned*)((const char*)(gbase) + (v0)), (LAS unsigned*)(lds + (bufoff) + ldsw), 16, 0, 0); \
        __builtin_amdgcn_global_load_lds((const unsigned*)((const char*)(gbase) + (v1)), (LAS unsigned*)(lds + (bufoff) + ldsw + 8192), 16, 0, 0); } while (0)
#define G_STAGE_B(bufoff, gbase) G_STAGE(bufoff, gbase, voffB[0], voffB[1])
#define G_LDA(dst, b, h) do { _Pragma("unroll") for (int m = 0; m < 4; ++m) _Pragma("unroll") for (int k = 0; k < 2; ++k) dst[m][k] = *(const LAS bf16x8*)(lds + G_SA(b, h) + (k ? aoff1 : aoff) + m * 2048); } while (0)
#define G_LDB(dst, b, h) do { _Pragma("unroll") for (int n = 0; n < 2; ++n) _Pragma("unroll") for (int k = 0; k < 2; ++k) dst[n][k] = *(const LAS bf16x8*)(lds + G_SB(b, h) + (k ? boff1 : boff) + n * 2048); } while (0)
#define G_MMA(ai, bj, At, Bt) do { __builtin_amdgcn_s_setprio(1); _Pragma("unroll") for (int m = 0; m < 4; ++m) _Pragma("unroll") for (int n = 0; n < 2; ++n) _Pragma("unroll") for (int k = 0; k < 2; ++k) \
        acc[ai][bj][m][n] = __builtin_amdgcn_mfma_f32_16x16x32_bf16(Bt[n][k], At[m][k], acc[ai][bj][m][n], 0, 0, 0); __builtin_amdgcn_s_setprio(0); } while (0)
#define G_WAIT_V(n) asm volatile("s_waitcnt vmcnt(" #n ")" ::: "memory")
#define G_WAIT_L(n) asm volatile("s_waitcnt lgkmcnt(" #n ")" ::: "memory")
#define G_BAR __builtin_amdgcn_s_barrier()
#define G_SCHED __builtin_amdgcn_sched_barrier(0)
    GU cur, nxt; int ui = 0;
    if (!gemm_unit<KIND>(X, l, 0, cur, mode)) return;
    if (KIND == K_UP) gather_voffA(X, cur, Rr, Cc, voc);
    if (KIND == K_DOWN) wait_count(X.ctl + CW_DONE + (l * 160 + cur.i0) * 16, 8u, X.ctl + CW_BAR + XB_TMO);
#define G_GATE_DMA(U, PAR) do { \
        if (KIND == K_OUT) { if (wid < 4) __builtin_amdgcn_global_load_lds((const unsigned*)(X.mod + (size_t)((l * 5 + row_mb((U).i0 * 256)) * 6 + 2) * 1024 + 256 * (U).i1 + 64 * wid + lane), \
                (LAS unsigned*)(lds + MISC_GATE + (PAR) * 1024 + wid * 256), 4, 0, 0); } \
        if (KIND == K_DOWN) { if (wid < 5) __builtin_amdgcn_global_load_lds((const unsigned*)(X.mod + (size_t)((l * 5 + wid) * 6 + 5) * 1024 + 256 * (U).i1 + 4 * lane), \
                (LAS unsigned*)(lds + MISC_GATE + 2048 + (PAR) * 5120 + wid * 1024), 16, 0, 0); } } while (0)
    G_GATE_DMA(cur, 0);
    f32x4 acc[2][2][4][2];
#pragma unroll
    for (int a = 0; a < 2; ++a)
#pragma unroll
        for (int b = 0; b < 2; ++b)
#pragma unroll
            for (int m = 0; m < 4; ++m)
#pragma unroll
                for (int n = 0; n < 2; ++n) acc[a][b][m][n] = (f32x4){0.f, 0.f, 0.f, 0.f};
    bf16x8 At[4][2], B0[2][2], B1[2][2];
    const char* cA = cur.a; const char* cB = cur.b; const char* cBh = cur.bh;
    G_STAGE_B(G_SB(0, 0), cB); G_STAGE_B(G_SB(0, 1), cB + bhstep); G_STAGE(G_SA(0, 0), cA, voc[0][0], voc[0][1]); G_STAGE(G_SA(0, 1), cA + ahstep, voc[1][0], voc[1][1]);
    if (wr == 1) G_BAR;
    G_WAIT_V(2); G_BAR;
    G_STAGE_B(G_SB(1, 0), cB + kstep); G_STAGE(G_SA(1, 0), cA + kstep, voc[0][0], voc[0][1]); G_STAGE_B(G_SB(1, 1), cB + bhstep + kstep);
    G_WAIT_V(6); G_BAR;
    for (;;) {
        const bool has_next = gemm_unit<KIND>(X, l, ui + 1, nxt, mode);
        if (KIND == K_UP) { if (has_next) gather_voffA(X, nxt, Rr, Cc, von); }
        if (KIND == K_DOWN) { if (has_next) wait_count(X.ctl + CW_DONE + (l * 160 + nxt.i0) * 16, 8u, X.ctl + CW_BAR + XB_TMO); }
        const char* nA = has_next ? nxt.a : cA; const char* nB = has_next ? nxt.b : cB;
        for (int t = 0; t < nt; t += 2) {
            const bool last = (t == nt - 2);
            const char* a1 = cA + (size_t)(t + 1) * kstep;
            const char* a2 = last ? nA : cA + (size_t)(t + 2) * kstep;
            const char* b2 = last ? nB : ((t + 2) < KS ? cB : cBh) + (size_t)(t + 2) * kstep;
            const char* a3 = a2 + kstep;
            const char* b3 = last ? nB + kstep : ((t + 3) < KS ? cB : cBh) + (size_t)(t + 3) * kstep;
            unsigned v00 = voc[0][0], v01 = voc[0][1], v10 = voc[1][0], v11 = voc[1][1];
            if (KIND == K_UP) { if (last && has_next) { v00 = von[0][0]; v01 = von[0][1]; v10 = von[1][0]; v11 = von[1][1]; } }
            G_LDB(B0, 0, 0); G_LDB(B1, 0, 1); G_SCHED; G_LDA(At, 0, 0); G_STAGE(G_SA(1, 1), a1 + ahstep, voc[1][0], voc[1][1]);
            G_WAIT_V(8); G_WAIT_L(0); G_BAR; G_MMA(0, 0, At, B0); G_MMA(0, 1, At, B1); G_BAR; G_SCHED;
            G_LDA(At, 0, 1); G_STAGE_B(G_SB(0, 0), b2); G_STAGE_B(G_SB(0, 1), b2 + bhstep); G_STAGE(G_SA(0, 0), a2, v00, v01);
            G_WAIT_V(8); G_WAIT_L(0); G_BAR; G_MMA(1, 0, At, B0); G_MMA(1, 1, At, B1); G_BAR; G_SCHED;
            G_LDB(B0, 1, 0); G_LDB(B1, 1, 1); G_SCHED; G_LDA(At, 1, 0); G_STAGE(G_SA(0, 1), a2 + ahstep, v10, v11);
            G_WAIT_V(8); G_WAIT_L(0); G_BAR; G_MMA(0, 0, At, B0); G_MMA(0, 1, At, B1); G_BAR; G_SCHED;
            G_LDA(At, 1, 1); G_STAGE_B(G_SB(1, 0), b3); G_STAGE_B(G_SB(1, 1), b3 + bhstep); G_STAGE(G_SA(1, 0), a3, v00, v01);
            G_WAIT_V(8); G_WAIT_L(0); G_BAR; G_MMA(1, 0, At, B0); G_MMA(1, 1, At, B1); G_BAR; G_SCHED;
        }
        if (ALIGN_EPI) { if (wr == 0) G_BAR; }
        G_SCHED;
        gemm_epilogue<KIND>(X, l, acc, cur, wr, wc, fr, fq, ui & 1);
        if (KIND == K_UP) {
            G_WAIT_V(0); G_BAR;
            if (tid == 0) (void)__hip_atomic_fetch_add(X.ctl + CW_DONE + (l * 160 + cur.i0) * 16, 1u, __ATOMIC_RELAXED, __HIP_MEMORY_SCOPE_AGENT); }
        if (!has_next) break;
#pragma unroll
        for (int a = 0; a < 2; ++a)
#pragma unroll
            for (int b = 0; b < 2; ++b)
#pragma unroll
                for (int m = 0; m < 4; ++m)
#pragma unroll
                    for (int n = 0; n < 2; ++n) acc[a][b][m][n] = (f32x4){0.f, 0.f, 0.f, 0.f};
        cur = nxt; cA = nxt.a; cB = nxt.b; cBh = nxt.bh; ++ui;
        G_GATE_DMA(cur, ui & 1);
        if (KIND == K_UP) {
#pragma unroll
            for (int h = 0; h < 2; ++h)
#pragma unroll
                for (int i = 0; i < 2; ++i) voc[h][i] = von[h][i]; }
        if (ALIGN_EPI) { if (wr == 1) G_BAR; }
    }
    G_WAIT_V(0);
    if (!ALIGN_EPI) { if (wr == 0) G_BAR; }
    G_BAR;
#undef G_GATE_DMA
#undef G_SA
#undef G_SB
#undef G_STAGE
#undef G_STAGE_B
#undef G_LDA
#undef G_LDB
#undef G_MMA
#undef G_WAIT_V
#undef G_WAIT_L
#undef G_BAR
#undef G_SCHED
}

constexpr int L_UC = 0, L_UCB = 16384, L_PRE = 24576, L_HOUT = 90112, L_SUB = 122880;
template <bool PASS2> DI void phase_lru(const Base& B, int l) {
    const Ctx X = make_ctx(B);
    LAS unsigned char* lds = X.lds;
    LAS f32x2* UC2 = (LAS f32x2*)(lds + L_UC);
    LAS bf16_t* UCB = (LAS bf16_t*)(lds + L_UCB);
    LAS f32x2* PRE2 = (LAS f32x2*)(lds + L_PRE);
    LAS f32x2* HOUT2 = (LAS f32x2*)(lds + L_HOUT);
    LAS f32x2* SUB = (LAS f32x2*)(lds + L_SUB);
    const int tid = X.tid, lane = X.lane, w = X.wave;
    const bf16_t* Ub = X.qkv + 3 * (QKV_STRIDE / 2); const bf16_t* Gb = X.qkv + 4 * (QKV_STRIDE / 2);
    const int tp = tid >> 4, c4 = tid & 15;
    const int gm = w >> 1, eh = w & 1, r32 = lane & 31, hh = lane >> 5;
    const int ch = lane, dir = w >> 2, sub = w & 3;
    const int NU = (PASS2 && l == DEPTH - 1) ? 512 * 8 : NCHUNK * 8;
    int cblk = -1; f32x4 cw[4], cbv; bf16x8 bfr[4]; float br = 0.f, bi = 0.f, sp = 0.f;
    u32x2 pu[5], pg[2]; float pc = 0.f;
#define LRU_LOAD(UN) do { const int g_ = (UN) >> 3, blk_ = (UN) & 7, tok0_ = g_ * 64; int s0_, s1_; \
        if (g_ < 512) { s0_ = (g_ >> 7) << 13; s1_ = s0_ + SEQ; } else { s0_ = RL + ((g_ - 512) >> 2) * CTX; s1_ = s0_ + CTX; } \
        _Pragma("unroll") for (int k_ = 0; k_ < 5; ++k_) { const int row_ = tok0_ + 2 * tp + k_ - 1; \
            if (row_ >= s0_ && row_ < s1_) pu[k_] = *(const u32x2*)(Ub + (size_t)row_ * 512 + blk_ * 64 + 4 * c4); else pu[k_] = (u32x2){0u, 0u}; } \
        if (PASS2) { pg[0] = *(const u32x2*)(Gb + (size_t)(tok0_ + 2 * tp) * 512 + blk_ * 64 + 4 * c4); pg[1] = *(const u32x2*)(Gb + (size_t)(tok0_ + 2 * tp + 1) * 512 + blk_ * 64 + 4 * c4); \
            pc = X.carry[(size_t)(g_ * 2 + dir) * 512 + blk_ * 64 + ch]; } } while (0)
    const bool rebal = !PASS2 && l < DEPTH - 1 && X.G == 256;
    auto unit_of = [&](int k) -> int {
        if (!rebal) { const int u_ = X.bid + k * X.G; return u_ < NU ? u_ : NU; }
        const int nb = X.bid >= 224 ? 14 : 16;
        if (k < nb) return X.bid + k * 256;
        if (k == nb && X.bid < 192) return X.bid < 128 ? 4096 + X.bid : 224 + ((X.bid - 128) & 31) + (14 + ((X.bid - 128) >> 5)) * 256;
        return NU; };
    if (unit_of(0) < NU) LRU_LOAD(unit_of(0));
    for (int kk = 0, un = unit_of(0); un < NU; un = unit_of(++kk)) {
        const int g = un >> 3, blk = un & 7, tok0 = g * 64;
        if (blk != cblk) { cblk = blk;
#pragma unroll
            for (int k = 0; k < 4; ++k) cw[k] = *(const f32x4*)(X.conv_w + (size_t)(l * 4 + k) * 512 + blk * 64 + 4 * c4);
            cbv = *(const f32x4*)(X.conv_b + l * 512 + blk * 64 + 4 * c4);
            const bf16_t* Wt = X.gatew + (size_t)(((l * 2 + (gm >> 1)) * 2 + (gm & 1)) * 8 + blk) * 4096;
#pragma unroll
            for (int ks = 0; ks < 4; ++ks) bfr[ks] = *(const bf16x8*)(Wt + (32 * eh + r32) * 64 + 16 * ks + 8 * hh);
            br = X.lru_b_r[(l * 2 + dir) * 512 + blk * 64 + ch]; bi = X.lru_b_i[(l * 2 + dir) * 512 + blk * 64 + ch]; sp = X.sp8[(l * 2 + dir) * 512 + blk * 64 + ch]; }
        u32x2 cu[5], cgv[2]; float cc;
#pragma unroll
        for (int k = 0; k < 5; ++k) cu[k] = pu[k];
        cgv[0] = pg[0]; cgv[1] = pg[1]; cc = pc;
        { const int nu_ = unit_of(kk + 1); if (nu_ < NU) LRU_LOAD(nu_); }
        { f32x4 uf[5];
#pragma unroll
          for (int k = 0; k < 5; ++k) uf[k] = (f32x4){bflo(cu[k].x), bfhi(cu[k].x), bflo(cu[k].y), bfhi(cu[k].y)};
          f32x4 a0 = cbv, a1 = cbv;
#pragma unroll
          for (int k = 0; k < 4; ++k) { a0 += uf[k] * cw[k]; a1 += uf[k + 1] * cw[k]; }
          LAS f32x2* up = UC2 + tp * 64 + 4 * c4;
          *(LAS f32x4*)(up) = (f32x4){a0.x, a1.x, a0.y, a1.y}; *(LAS f32x4*)(up + 2) = (f32x4){a0.z, a1.z, a0.w, a1.w};
          *(LAS u32x2*)(UCB + ((c4 >> 1) * 64 + 2 * tp) * 8 + 4 * (c4 & 1)) = (u32x2){pk2(a0.x, a0.y), pk2(a0.z, a0.w)};
          *(LAS u32x2*)(UCB + ((c4 >> 1) * 64 + 2 * tp + 1) * 8 + 4 * (c4 & 1)) = (u32x2){pk2(a1.x, a1.y), pk2(a1.z, a1.w)}; }
        __syncthreads();
#pragma unroll
        for (int mb = 0; mb < 2; ++mb) { f32x16 c16;
#pragma unroll
            for (int i = 0; i < 16; ++i) c16[i] = 0.f;
#pragma unroll
            for (int ks = 0; ks < 4; ++ks) { const bf16x8 af = *(const LAS bf16x8*)(UCB + ((2 * ks + hh) * 64 + 32 * mb + r32) * 8); c16 = __builtin_amdgcn_mfma_f32_32x32x16_bf16(af, bfr[ks], c16, 0, 0, 0); }
#pragma unroll
            for (int i = 0; i < 16; i += 2) { const int tkk = 32 * mb + (i & 3) + 8 * (i >> 2) + 4 * hh;
                PRE2[(gm * 32 + (tkk >> 1)) * 64 + 32 * eh + r32] = (f32x2){c16[i], c16[i + 1]}; } }
        __syncthreads();
        float hl[16], al[16];
        { float h = 0.f, ac = 1.f; const float spl = sp * LOG2E;
          u32x2* abp = PASS2 ? nullptr : ab_ptr(X, tok0, dir) + blk * 64 + ch;
#define LRU_PAIR_LD(DIRV, kp) do { const int tpp = (DIRV) ? (8 * sub + 7 - (kp)) : (8 * sub + (kp)); \
              zrv[(kp) & 3] = PRE2[((2 * (DIRV)) * 32 + tpp) * 64 + ch]; ziv[(kp) & 3] = PRE2[((2 * (DIRV) + 1) * 32 + tpp) * 64 + ch]; ucv[(kp) & 3] = UC2[tpp * 64 + ch]; } while (0)
#define LRU_PAIR(DIRV, kp) do { const int tpp = (DIRV) ? (8 * sub + 7 - (kp)) : (8 * sub + (kp)); \
              const f32x2 zr = zrv[(kp) & 3] + br, zi = ziv[(kp) & 3] + bi, uc = ucv[(kp) & 3]; \
              f32x2 er = zr * (-LOG2E), ei = zi * (-LOG2E); \
              er.x = fexp2(er.x); er.y = fexp2(er.y); ei.x = fexp2(ei.x); ei.y = fexp2(ei.y); \
              er += 1.0f; ei += 1.0f; \
              f32x2 rg, ig; rg.x = frcp(er.x); rg.y = frcp(er.y); ig.x = frcp(ei.x); ig.y = frcp(ei.y); \
              f32x2 a = rg * (-spl); a.x = fexp2(a.x); a.y = fexp2(a.y); \
              const f32x2 om = 1.0f - a * a;                        \
              f32x2 bb; bb.x = __builtin_amdgcn_sqrtf(om.x); bb.y = __builtin_amdgcn_sqrtf(om.y); \
              bb = bb * ig * uc; \
              if (!PASS2) { const f32x2 oa = 1.0f - a;           \
                  st_wt_b64(abp + tpp * 1024, (u32x2){__builtin_bit_cast(unsigned, __builtin_convertvector((f32x2){oa.x, bb.x}, h16x2)), __builtin_bit_cast(unsigned, __builtin_convertvector((f32x2){oa.y, bb.y}, h16x2))}); } \
              const float a0 = (DIRV) ? a.y : a.x, a1 = (DIRV) ? a.x : a.y, b0 = (DIRV) ? bb.y : bb.x, b1 = (DIRV) ? bb.x : bb.y; \
              h = a0 * h + b0; ac *= a0; hl[2 * (kp)] = h; al[2 * (kp)] = ac; \
              h = a1 * h + b1; ac *= a1; hl[2 * (kp) + 1] = h; al[2 * (kp) + 1] = ac; } while (0)
          f32x2 zrv[4], ziv[4], ucv[4];
          if (dir == 0) {
#pragma unroll
              for (int k4 = 0; k4 < 8; k4 += 4) {
#pragma unroll
                  for (int kp = k4; kp < k4 + 4; ++kp) LRU_PAIR_LD(0, kp);
#pragma unroll
                  for (int kp = k4; kp < k4 + 4; ++kp) LRU_PAIR(0, kp); } }
          else {
#pragma unroll
              for (int k4 = 0; k4 < 8; k4 += 4) {
#pragma unroll
                  for (int kp = k4; kp < k4 + 4; ++kp) LRU_PAIR_LD(1, kp);
#pragma unroll
                  for (int kp = k4; kp < k4 + 4; ++kp) LRU_PAIR(1, kp); } }
#undef LRU_PAIR
#undef LRU_PAIR_LD
          SUB[(dir * 4 + sub) * 64 + ch] = (f32x2){ac, h}; }
        __syncthreads();
        if (!PASS2) {
            if (sub == (dir ? 0 : 3)) { float S = 0.f, At = 1.f;
#pragma unroll
                for (int j = 0; j < 4; ++j) { const int sb = dir ? 3 - j : j; const f32x2 ah = SUB[(dir * 4 + sb) * 64 + ch]; S = ah.x * S + ah.y; At *= ah.x; }
                st_wt_b64(X.agg + (size_t)(g * 2 + dir) * 512 + blk * 64 + ch, __builtin_bit_cast(u32x2, (f32x2){At, S})); }
        } else {
            float S = cc;
#pragma unroll
            for (int j = 0; j < 3; ++j) { const int sb = dir ? 3 - j : j; const bool take = dir ? (sb > sub) : (sb < sub); if (take) { const f32x2 ah = SUB[(dir * 4 + sb) * 64 + ch]; S = ah.x * S + ah.y; } }
#pragma unroll
            for (int kp = 0; kp < 8; ++kp) { const int tpp = dir ? (8 * sub + 7 - kp) : (8 * sub + kp);
                const float v0 = hl[2 * kp] + al[2 * kp] * S, v1 = hl[2 * kp + 1] + al[2 * kp + 1] * S;
                HOUT2[(dir * 32 + tpp) * 64 + ch] = dir ? (f32x2){v1, v0} : (f32x2){v0, v1}; }
            __syncthreads();
            { const LAS f32x2* hf = HOUT2 + tp * 64 + 4 * c4; const LAS f32x2* hr = HOUT2 + (32 + tp) * 64 + 4 * c4;
              const f32x4 f0 = *(const LAS f32x4*)(hf), f1 = *(const LAS f32x4*)(hf + 2), r0 = *(const LAS f32x4*)(hr), r1 = *(const LAS f32x4*)(hr + 2);
              const float sA0 = f0.x + r0.x, sB0 = f0.y + r0.y, sA1 = f0.z + r0.z, sB1 = f0.w + r0.w, sA2 = f1.x + r1.x, sB2 = f1.y + r1.y, sA3 = f1.z + r1.z, sB3 = f1.w + r1.w;
              const u32x2 gA = cgv[0], gB = cgv[1];
              u32x2 oA, oB;
              oA.x = pk2(gelu_tanh(bflo(gA.x)) * sA0, gelu_tanh(bfhi(gA.x)) * sA1); oA.y = pk2(gelu_tanh(bflo(gA.y)) * sA2, gelu_tanh(bfhi(gA.y)) * sA3);
              oB.x = pk2(gelu_tanh(bflo(gB.x)) * sB0, gelu_tanh(bfhi(gB.x)) * sB1); oB.y = pk2(gelu_tanh(bflo(gB.y)) * sB2, gelu_tanh(bfhi(gB.y)) * sB3);
              *(u32x2*)(X.hb + (size_t)(tok0 + 2 * tp) * D + 512 + blk * 64 + 4 * c4) = oA;
              *(u32x2*)(X.hb + (size_t)(tok0 + 2 * tp + 1) * D + 512 + blk * 64 + 4 * c4) = oB; }
        }
        __syncthreads();
    }
#undef LRU_LOAD
    if (!PASS2) {
        asm volatile("s_waitcnt vmcnt(0)" ::: "memory"); __syncthreads();
        if (X.tid == 0) (void)__hip_atomic_fetch_add(X.ctl + CW_CDONE + l * 16, 1u, __ATOMIC_RELAXED, __HIP_MEMORY_SCOPE_AGENT); }
}

DI void phase_lru2(const Base& B, int l) {
    const Ctx X = make_ctx(B);
    LAS unsigned char* lds = X.lds;
    LAS f32x2* HOUT2 = (LAS f32x2*)(lds + L_HOUT);
    LAS f32x2* SUB = (LAS f32x2*)(lds + L_SUB);
    const int tid = X.tid, lane = X.lane, w = X.wave;
    const bf16_t* Gb = X.qkv + 4 * (QKV_STRIDE / 2);
    const int tp = tid >> 4, c4 = tid & 15;
    const int ch = lane, dir = w >> 2, sub = w & 3;
    const bool cx = l < DEPTH - 1;
    const int NU = cx ? NCHUNK * 8 : 512 * 8, nbl = cx ? X.G - NCTX_OUT : X.G;
    wait_count(X.ctl + CW_CARRY + l * 64, 32u, X.ctl + CW_BAR + XB_TMO);
    const __amdgpu_buffer_rsrc_t hrs = __builtin_amdgcn_make_buffer_rsrc((void*)X.hb, 0, (int)((size_t)R * 2048), 0x00020000);
    u32x2 pab[8]; u32x2 pg[2]; float pc = 0.f;
#define LRU2_G(UN) (cx ? (((UN) >> 3) < 16 ? 512 + ((UN) >> 3) : ((UN) >> 3) - 16) : ((UN) >> 3))
#define LRU2_LOAD(UN) do { const int g_ = LRU2_G(UN), blk_ = (UN) & 7, tok0_ = g_ * 64; \
        { const u32x2* ap_ = ab_ptr(X, tok0_, dir) + blk_ * 64 + ch; _Pragma("unroll") for (int k_ = 0; k_ < 8; ++k_) pab[k_] = __builtin_nontemporal_load(ap_ + (dir ? 8 * sub + 7 - k_ : 8 * sub + k_) * 1024); } \
        pg[0] = *(const u32x2*)(Gb + (size_t)(tok0_ + 2 * tp) * 512 + blk_ * 64 + 4 * c4); pg[1] = *(const u32x2*)(Gb + (size_t)(tok0_ + 2 * tp + 1) * 512 + blk_ * 64 + 4 * c4); \
        pc = X.carry[(size_t)(g_ * 2 + dir) * 512 + blk_ * 64 + ch]; } while (0)
    if (X.bid < NU) LRU2_LOAD(X.bid);
    for (int un = X.bid; un < NU; un += nbl) {
        const int g = LRU2_G(un), blk = un & 7, tok0 = g * 64;
        u32x2 cab[8]; u32x2 cgv[2]; float cc;
#pragma unroll
        for (int k = 0; k < 8; ++k) cab[k] = pab[k];
        cgv[0] = pg[0]; cgv[1] = pg[1]; cc = pc;
        if (un + nbl < NU) LRU2_LOAD(un + nbl);
        float hl[16], al[16];
        { float h = 0.f, ac = 1.f;
#pragma unroll
          for (int kp = 0; kp < 8; ++kp) {
              const unsigned w0 = dir ? cab[kp].y : cab[kp].x, w1 = dir ? cab[kp].x : cab[kp].y;
              const h16x2 f0 = __builtin_bit_cast(h16x2, w0), f1 = __builtin_bit_cast(h16x2, w1);
              const float a0 = 1.0f - (float)f0.x, a1 = 1.0f - (float)f1.x;
              h = a0 * h + (float)f0.y; ac *= a0; hl[2 * kp] = h; al[2 * kp] = ac;
              h = a1 * h + (float)f1.y; ac *= a1; hl[2 * kp + 1] = h; al[2 * kp + 1] = ac; }
          SUB[(dir * 4 + sub) * 64 + ch] = (f32x2){ac, h}; }
        __syncthreads();
        { float S = cc;
#pragma unroll
          for (int j = 0; j < 3; ++j) { const int sb = dir ? 3 - j : j; const bool take = dir ? (sb > sub) : (sb < sub); if (take) { const f32x2 ah = SUB[(dir * 4 + sb) * 64 + ch]; S = ah.x * S + ah.y; } }
#pragma unroll
          for (int kp = 0; kp < 8; ++kp) { const int tpp = dir ? (8 * sub + 7 - kp) : (8 * sub + kp);
              const float v0 = hl[2 * kp] + al[2 * kp] * S, v1 = hl[2 * kp + 1] + al[2 * kp + 1] * S;
              HOUT2[(dir * 32 + tpp) * 64 + ch] = dir ? (f32x2){v1, v0} : (f32x2){v0, v1}; } }
        __syncthreads();
        { const LAS f32x2* hf = HOUT2 + tp * 64 + 4 * c4; const LAS f32x2* hr = HOUT2 + (32 + tp) * 64 + 4 * c4;
          const f32x4 f0 = *(const LAS f32x4*)(hf), f1 = *(const LAS f32x4*)(hf + 2), r0 = *(const LAS f32x4*)(hr), r1 = *(const LAS f32x4*)(hr + 2);
          const float sA0 = f0.x + r0.x, sB0 = f0.y + r0.y, sA1 = f0.z + r0.z, sB1 = f0.w + r0.w, sA2 = f1.x + r1.x, sB2 = f1.y + r1.y, sA3 = f1.z + r1.z, sB3 = f1.w + r1.w;
          const u32x2 gA = cgv[0], gB = cgv[1];
          u32x2 oA, oB;
          oA.x = pk2(gelu_tanh(bflo(gA.x)) * sA0, gelu_tanh(bfhi(gA.x)) * sA1); oA.y = pk2(gelu_tanh(bflo(gA.y)) * sA2, gelu_tanh(bfhi(gA.y)) * sA3);
          oB.x = pk2(gelu_tanh(bflo(gB.x)) * sB0, gelu_tanh(bfhi(gB.x)) * sB1); oB.y = pk2(gelu_tanh(bflo(gB.y)) * sB2, gelu_tanh(bfhi(gB.y)) * sB3);
          if (g >= 512) {
              __builtin_amdgcn_raw_buffer_store_b64(oA, hrs, (int)(((size_t)(tok0 + 2 * tp) * D + 512 + blk * 64 + 4 * c4) * 2), 0, 16);
              __builtin_amdgcn_raw_buffer_store_b64(oB, hrs, (int)(((size_t)(tok0 + 2 * tp + 1) * D + 512 + blk * 64 + 4 * c4) * 2), 0, 16);
              asm volatile("s_waitcnt vmcnt(0)" ::: "memory"); }
          else { *(u32x2*)(X.hb + (size_t)(tok0 + 2 * tp) * D + 512 + blk * 64 + 4 * c4) = oA;
                 *(u32x2*)(X.hb + (size_t)(tok0 + 2 * tp + 1) * D + 512 + blk * 64 + 4 * c4) = oB; } }
        __syncthreads();
        if (g >= 512 && tid == 0) (void)__hip_atomic_fetch_add(X.ctl + CW_ECTX + l * 64, 1u, __ATOMIC_RELAXED, __HIP_MEMORY_SCOPE_AGENT);
    }
#undef LRU2_LOAD
#undef LRU2_G
}

DI void carry_prop(const Ctx& X, int cb) {
    LAS f32x2* XS = (LAS f32x2*)(X.lds);
    const int pi = cb >> 2, b = pi >> 1, dir = pi & 1, seg = X.tid >> 7, ch = 128 * (cb & 3) + (X.tid & 127);
    f32x2 cx[4], ah[32];
#pragma unroll
    for (int j = 0; j < 4; ++j) { const int c = dir ? 3 - j : j, g = 512 + 4 * b + c; cx[j] = X.agg[(size_t)(g * 2 + dir) * 512 + ch]; }
#pragma unroll
    for (int k = 0; k < 32; ++k) { const int j = 32 * seg + k, c = dir ? 127 - j : j, g = 128 * b + c; ah[k] = X.agg[(size_t)(g * 2 + dir) * 512 + ch]; }
    float S = 0.f;
#pragma unroll
    for (int j = 0; j < 4; ++j) { const int c = dir ? 3 - j : j, g = 512 + 4 * b + c; if (seg == 0) st_wt_b32(X.carry + (size_t)(g * 2 + dir) * 512 + ch, S); S = cx[j].x * S + cx[j].y; }
    float As = 1.f, Hs = 0.f;
#pragma unroll
    for (int k = 0; k < 32; ++k) { Hs = ah[k].x * Hs + ah[k].y; As *= ah[k].x; }
    XS[seg * 128 + (X.tid & 127)] = (f32x2){As, Hs};
    __syncthreads();
#pragma unroll
    for (int sp = 0; sp < 3; ++sp) if (sp < seg) { const f32x2 t = XS[sp * 128 + (X.tid & 127)]; S = t.x * S + t.y; }
#pragma unroll
    for (int k = 0; k < 32; ++k) { const int j = 32 * seg + k, c = dir ? 127 - j : j, g = 128 * b + c; st_wt_b32(X.carry + (size_t)(g * 2 + dir) * 512 + ch, S); S = ah[k].x * S + ah[k].y; }
    asm volatile("s_waitcnt vmcnt(0)" ::: "memory");
    __syncthreads();
}
DI void phase_carry(const Base& B, int l) {
    const Ctx X = make_ctx(B);
    wait_count(X.ctl + CW_CDONE + l * 16, (unsigned)X.G, X.ctl + CW_BAR + XB_TMO);
    carry_prop(X, X.bid - (X.G - 64));
    if (X.tid == 0) (void)__hip_atomic_fetch_add(X.ctl + CW_CARRY + l * 64, 1u, __ATOMIC_RELAXED, __HIP_MEMORY_SCOPE_AGENT);
}
DI int row0_of(int r) { const int v = r - 4; return v < 0 ? 0 : (v > 120 ? 120 : v); }
constexpr int A_STG = 16384, A_NSTG = 4, A_TBL = A_STG * A_NSTG;
#define ATT_SOFTMAX1(P)  do { float ps_ = 0.f, pt_ = 0.f; \
        _Pragma("unroll") for (int i_ = 0; i_ < 16; i_ += 2) { P[i_] = fexp2(P[i_]); P[i_ + 1] = fexp2(P[i_ + 1]); ps_ += P[i_]; pt_ += P[i_ + 1]; } \
        lrun += ps_ + pt_; } while (0)
#define ATT_PACK(P, sx) __builtin_bit_cast(bf16x8, (u32x4){pk2(P[8 * (sx)], P[8 * (sx) + 1]), pk2(P[8 * (sx) + 2], P[8 * (sx) + 3]), pk2(P[8 * (sx) + 4], P[8 * (sx) + 5]), pk2(P[8 * (sx) + 6], P[8 * (sx) + 7])})
#define ATT_DMA(stage, ktok) do { const bf16_t* kb_ = Kb + (size_t)(ktok) * 512 + 64 * h; const bf16_t* vb_ = Vb + (size_t)(ktok) * 512 + 64 * h; \
        __builtin_amdgcn_global_load_lds((const unsigned*)(kb_ + kso), (LAS unsigned*)(lds + (stage) * A_STG + w * 1024), 16, 0, 0); \
        __builtin_amdgcn_global_load_lds((const unsigned*)(vb_ + vso), (LAS unsigned*)(lds + (stage) * A_STG + 8192 + w * 1024), 16, 0, 0); } while (0)
#define ATT_KTOK(st) ((st) < nwin ? (b * SEQ + 64 * (krlo + (st))) : (RL + b * CTX + 64 * ((st) - nwin)))
#define ATT_VREAD(VB, IMM0, VL, VH) do { \
        _Pragma("unroll") for (int db_ = 0; db_ < 2; ++db_) _Pragma("unroll") for (int sx_ = 0; sx_ < 2; ++sx_) { \
            asm volatile("ds_read_b64_tr_b16 %0, %1 offset:%c2" : "=&v"(VL[db_][sx_]) : "v"(VB), "i"((IMM0) + db_ * 4096 + sx_ * 1024) : "memory"); \
            asm volatile("ds_read_b64_tr_b16 %0, %1 offset:%c2" : "=&v"(VH[db_][sx_]) : "v"(VB), "i"((IMM0) + db_ * 4096 + sx_ * 1024 + 512) : "memory"); } } while (0)
#define ATT_LGKM0() do { asm volatile("s_waitcnt lgkmcnt(0)" ::: "memory"); __builtin_amdgcn_sched_barrier(0); } while (0)
#define ATT_PVMMA(VL, VH, PF0, PF1) do { \
        _Pragma("unroll") for (int sx_ = 0; sx_ < 2; ++sx_) { \
            const bf16x8 va_ = (bf16x8){VL[0][sx_][0], VL[0][sx_][1], VL[0][sx_][2], VL[0][sx_][3], VH[0][sx_][0], VH[0][sx_][1], VH[0][sx_][2], VH[0][sx_][3]}; \
            const bf16x8 vb_ = (bf16x8){VL[1][sx_][0], VL[1][sx_][1], VL[1][sx_][2], VL[1][sx_][3], VH[1][sx_][0], VH[1][sx_][1], VH[1][sx_][2], VH[1][sx_][3]}; \
            o0 = __builtin_amdgcn_mfma_f32_32x32x16_bf16(va_, sx_ ? (PF1) : (PF0), o0, 0, 0, 0); o1 = __builtin_amdgcn_mfma_f32_32x32x16_bf16(vb_, sx_ ? (PF1) : (PF0), o1, 0, 0, 0); } } while (0)
template <int ST> DI void att_step(LAS unsigned char* lds, int s, int nsteps, int nwin, int krlo, int wlo, int whi, int myr0, int qrow, int cs, int r32, int hh, unsigned vwin, unsigned vctx,
                                   unsigned kso, unsigned vso, int w, int h, int b, const bf16_t* Kb, const bf16_t* Vb, const LAS float* TBL, const unsigned (&bp)[4], const bf16x8 (&qf)[4],
                                   f32x16& o0, f32x16& o1, float mref, float& lrun) {
    const int rem = nsteps - 1 - s;
    TP_BEGIN(20, tpa_)
    if (rem >= 2) asm volatile("s_waitcnt vmcnt(4) lgkmcnt(0)" ::: "memory"); else if (rem == 1) asm volatile("s_waitcnt vmcnt(2) lgkmcnt(0)" ::: "memory"); else asm volatile("s_waitcnt vmcnt(0) lgkmcnt(0)" ::: "memory");
    TP_BEGIN(23, tpd_)
    __builtin_amdgcn_s_barrier(); asm volatile("" ::: "memory");
    TP_END(20, tpa_, lds); TP_END(23, tpd_, lds);
    TP_BEGIN(21, tpb_)
    if (s + 3 < nsteps) ATT_DMA((ST + 3) & 3, ATT_KTOK(s + 3));
    const LAS unsigned char* Kt = lds + ST * A_STG;
    if (s < nwin) {
        const int kr = krlo + s;
        if (kr >= wlo && kr <= whi) {
            const int ri = (kr >= myr0 && kr < myr0 + 8) ? (kr - qrow + 7) : 15;
            const LAS float* trow = TBL + ri * 32;
            f32x16 p; bf16x8 kf[4]; s16x4 vl[2][2], vh[2][2];
            unsigned b4[16];
            { unsigned w0 = bp[0], w1 = bp[1], w2 = bp[2], w3 = bp[3]; asm volatile("" : "+v"(w0), "+v"(w1), "+v"(w2), "+v"(w3));
#pragma unroll
              for (int i = 0; i < 16; ++i) { const unsigned wv = (i >> 2) == 0 ? w0 : ((i >> 2) == 1 ? w1 : ((i >> 2) == 2 ? w2 : w3)); b4[i] = (wv >> (8 * (i & 3))) & 0xffu; } }
            TP_BEGIN(22, tpc_)
#pragma unroll
            for (int i = 0; i < 16; ++i) p[i] = *(const LAS float*)((const LAS unsigned char*)trow + b4[i]);
#pragma unroll
            for (int ks = 0; ks < 4; ++ks) kf[ks] = *(const LAS bf16x8*)(Kt + (2 * ks + hh) * 1024 + (cs + r32) * 16);
            ATT_VREAD(vwin, ST * A_STG + 8192, vl, vh);
            ATT_LGKM0();
            TP_END(22, tpc_, lds);
#pragma unroll
            for (int ks = 0; ks < 4; ++ks) p = __builtin_amdgcn_mfma_f32_32x32x16_bf16(kf[ks], qf[ks], p, 0, 0, 0);
            ATT_SOFTMAX1(p);
            const bf16x8 pf0 = ATT_PACK(p, 0), pf1 = ATT_PACK(p, 1);
            ATT_PVMMA(vl, vh, pf0, pf1);
        }
    } else {
        f32x16 pa, pb; bf16x8 kf0[4], kf1[4]; s16x4 vl0[2][2], vh0[2][2], vl1[2][2], vh1[2][2];
        float nm = -mref; asm volatile("" : "+v"(nm));
#pragma unroll
        for (int ks = 0; ks < 4; ++ks) kf0[ks] = *(const LAS bf16x8*)(Kt + (2 * ks + hh) * 1024 + r32 * 16);
        ATT_VREAD(vctx, ST * A_STG + 8192, vl0, vh0);
        ATT_LGKM0();
#pragma unroll
        for (int i = 0; i < 16; ++i) pa[i] = nm;
#pragma unroll
        for (int ks = 0; ks < 4; ++ks) pa = __builtin_amdgcn_mfma_f32_32x32x16_bf16(kf0[ks], qf[ks], pa, 0, 0, 0);
        __builtin_amdgcn_sched_barrier(0);
#pragma unroll
        for (int ks = 0; ks < 4; ++ks) kf1[ks] = *(const LAS bf16x8*)(Kt + (2 * ks + hh) * 1024 + (32 + r32) * 16);
        ATT_VREAD(vctx, ST * A_STG + 8192 + 2048, vl1, vh1);
        __builtin_amdgcn_sched_barrier(0);
        ATT_SOFTMAX1(pa);
        { const bf16x8 pf0 = ATT_PACK(pa, 0), pf1 = ATT_PACK(pa, 1); ATT_PVMMA(vl0, vh0, pf0, pf1); }
        ATT_LGKM0();
#pragma unroll
        for (int i = 0; i < 16; ++i) pb[i] = nm;
#pragma unroll
        for (int ks = 0; ks < 4; ++ks) pb = __builtin_amdgcn_mfma_f32_32x32x16_bf16(kf1[ks], qf[ks], pb, 0, 0, 0);
        ATT_SOFTMAX1(pb);
        { const bf16x8 pf0 = ATT_PACK(pb, 0), pf1 = ATT_PACK(pb, 1); ATT_PVMMA(vl1, vh1, pf0, pf1); }
    }
    if (TPROF == 21) { asm volatile("s_nop 0" :: "v"(o0[0]), "v"(o1[0]), "v"(lrun)); }
    TP_END(21, tpb_, lds);
}
DI void phase_attn(const Base& B, int l, int mode) {
    const Ctx X = make_ctx(B);
    LAS unsigned char* lds = X.lds;
    LAS float* TBL = (LAS float*)(lds + A_TBL);
    const int tid = X.tid, lane = X.lane, w = X.wave, r32 = lane & 31, hh = lane >> 5;
    const bf16_t* Qb = X.qkv; const bf16_t* Kb = X.qkv + (QKV_STRIDE / 2); const bf16_t* Vb = X.qkv + 2 * (QKV_STRIDE / 2);
    const int nunits = mode == 1 ? 1056 : ((l == DEPTH - 1 || mode == 0) ? 1024 : 1056), un0 = mode == 1 ? 1024 + X.bid - (X.G - 32) : X.bid;
    const unsigned kso = (unsigned)(lane * 512 + 8 * w), vso = (unsigned)((16 * (w & 3) + (lane >> 2)) * 512 + 32 * (w >> 2) + 8 * (lane & 3));
    const unsigned vlane = (unsigned)((4 * hh + ((lane & 15) >> 2)) * 64 + (16 * ((lane >> 4) & 1) + 4 * (lane & 3)) * 2);
    const unsigned ldsb = (unsigned)(size_t)lds;
    const int rp = w >> 2, jb = w & 3, qcol = 16 * jb + (r32 & 15);
    int cs = 16 * jb - 8; cs = cs < 0 ? 0 : (cs > 32 ? 32 : cs);
    unsigned bp[4] = {0u, 0u, 0u, 0u};
    { int c0 = qcol - 8; c0 = c0 < 0 ? 0 : (c0 > 48 ? 48 : c0);
#pragma unroll
      for (int i = 0; i < 16; ++i) { const int kc = cs + (i & 3) + 8 * (i >> 2) + 4 * hh; const int bi = (kc >= c0 && kc < c0 + 16) ? (kc - qcol + 15) : 31; bp[i >> 2] |= (unsigned)(bi * 4) << (8 * (i & 3)); } }
    const unsigned vctx = ldsb + vlane, vwin = vctx + (unsigned)cs * 64u;
    float mref;
    { float gq = fabsf(X.q_gain[l * 64 + lane]), gk = fabsf(X.k_gain[l * 64 + lane]);
#pragma unroll
      for (int o = 1; o < 64; o <<= 1) { gq = fmaxf(gq, shflx(gq, o, lane)); gk = fmaxf(gk, shflx(gk, o, lane)); }
      mref = 8.0f * LOG2E * gq * gk; }
    int tbl_h = -1;
    auto q_load = [&](int u_, bf16x8 (&q)[4]) { int qt_, h_;
        if (u_ < 1024) { h_ = (u_ >> 5) & 7; qt_ = (u_ >> 8) * SEQ + 64 * (4 * (u_ & 31) + 2 * rp + (r32 >> 4)) + qcol; } else { const int v_ = u_ - 1024; h_ = v_ & 7; qt_ = RL + (v_ >> 3) * CTX + 32 * w + r32; }
#pragma unroll
        for (int ks = 0; ks < 4; ++ks) q[ks] = *(const bf16x8*)(Qb + (size_t)qt_ * 512 + 64 * h_ + 16 * ks + 8 * hh); };
    bf16x8 qf[4], qn[4];
#pragma unroll
    for (int ks = 0; ks < 4; ++ks) { qf[ks] = (bf16x8){0, 0, 0, 0, 0, 0, 0, 0}; qn[ks] = qf[ks]; }
    if (un0 < nunits) q_load(un0, qf);
    for (int un = un0; un < nunits; un += X.G) {
        const bool lat = un < 1024;
        int b, h, r0 = 0;
        if (lat) { b = un >> 8; h = (un >> 5) & 7; r0 = 4 * (un & 31); } else { const int v = un - 1024; b = v >> 3; h = v & 7; }
        int krlo = 0, nwin = 0, qrow = 0, myr0 = 0, wlo = 0, whi = 0, qtok;
        if (lat) { krlo = row0_of(r0); nwin = row0_of(r0 + 3) + 8 - krlo; const int ra = r0 + 2 * rp; qrow = ra + (r32 >> 4); myr0 = row0_of(qrow); wlo = row0_of(ra); whi = row0_of(ra + 1) + 7;
            qtok = b * SEQ + 64 * qrow + qcol; }
        else qtok = RL + b * CTX + 32 * w + r32;
        const int nsteps = nwin + 4;
        ATT_DMA(0, ATT_KTOK(0)); ATT_DMA(1, ATT_KTOK(1)); ATT_DMA(2, ATT_KTOK(2));
        if (lat && h != tbl_h) { tbl_h = h;
            for (int i = tid; i < 16 * 32; i += 512) { const int ri = i >> 5, ci = i & 31; TBL[i] = (ci < 31 && ri < 15) ? X.na_bias[((size_t)(l * 8 + h) * 15 + ri) * 31 + ci] * LOG2E - mref : NEGBIG; } }
        const bool more = un + X.G < nunits;
        if (more) q_load(un + X.G, qn);
        f32x16 o0, o1;
#pragma unroll
        for (int i = 0; i < 16; ++i) { o0[i] = 0.f; o1[i] = 0.f; }
        float lrun = 0.f;
#define ATT_STEP(ST, sv) att_step<ST>(lds, sv, nsteps, nwin, krlo, wlo, whi, myr0, qrow, cs, r32, hh, vwin, vctx, kso, vso, w, h, b, Kb, Vb, TBL, bp, qf, o0, o1, mref, lrun)
        for (int s0 = 0; s0 < nsteps; s0 += 4) {
            ATT_STEP(0, s0);
            if (s0 + 1 < nsteps) ATT_STEP(1, s0 + 1);
            if (s0 + 2 < nsteps) ATT_STEP(2, s0 + 2);
            if (s0 + 3 < nsteps) ATT_STEP(3, s0 + 3);
        }
#undef ATT_STEP
        asm volatile("" ::: "memory"); __builtin_amdgcn_s_barrier(); asm volatile("" ::: "memory");
        if (more) {
#pragma unroll
            for (int ks = 0; ks < 4; ++ks) asm volatile("" : "+v"(qn[ks])); }
        { const float lt = lrun + shflx(lrun, 32, lane), inv = frcp(lt);
          bf16_t* op = X.hb + (size_t)qtok * D + 64 * h + 4 * hh;
#pragma unroll
          for (int gq = 0; gq < 4; ++gq) { u32x2 a, c; a.x = pk2(o0[4 * gq] * inv, o0[4 * gq + 1] * inv); a.y = pk2(o0[4 * gq + 2] * inv, o0[4 * gq + 3] * inv);
              c.x = pk2(o1[4 * gq] * inv, o1[4 * gq + 1] * inv); c.y = pk2(o1[4 * gq + 2] * inv, o1[4 * gq + 3] * inv);
              if (lat) { *(u32x2*)(op + 8 * gq) = a; *(u32x2*)(op + 32 + 8 * gq) = c; }
              else { st_wt_b64(op + 8 * gq, a); st_wt_b64(op + 32 + 8 * gq, c); } } }
        if (!lat) { asm volatile("s_waitcnt vmcnt(0)" ::: "memory"); __builtin_amdgcn_s_barrier(); asm volatile("" ::: "memory");
            if (tid == 0) (void)__hip_atomic_fetch_add(X.ctl + CW_ECTX + l * 64, 1u, __ATOMIC_RELAXED, __HIP_MEMORY_SCOPE_AGENT); }
#pragma unroll
        for (int ks = 0; ks < 4; ++ks) qf[ks] = qn[ks];
    }
}
#undef ATT_SOFTMAX1
#undef ATT_PACK
#undef ATT_VREAD
#undef ATT_LGKM0
#undef ATT_PVMMA
#undef ATT_DMA
#undef ATT_KTOK

constexpr int G_RWP = 1032, G_RWH = 0, G_RWL = G_RWH + 16 * G_RWP * 2, G_GM = G_RWL + 16 * G_RWP * 2, G_SH = G_GM + 5 * 1024 * 4, G_LG = G_SH + 5 * 1024 * 4,
              G_SELC = G_LG + 272 * 16 * 4, G_SELW = G_SELC + 272 * 4, G_CNT = G_SELW + 272 * 8, G_BASE = G_CNT + 128;
static_assert(G_BASE + 128 <= LDS_MISC, "router LDS map");
DI void phase_router(const Base& B, int l, int dummy) {
    Ctx X = make_ctx(B);
    if (dummy) { X.list += 13 * (MiB / 4); X.wtl += 13 * (MiB / 8); }
    const int cwc = CW_CLS + (dummy ? 128 : 0) + l * 32;
    LAS unsigned char* lds = X.lds;
    LAS bf16_t* RWH = (LAS bf16_t*)(lds + G_RWH); LAS bf16_t* RWL = (LAS bf16_t*)(lds + G_RWL);
    LAS float* GM = (LAS float*)(lds + G_GM); LAS float* SHT = (LAS float*)(lds + G_SH);
    LAS float* LG = (LAS float*)(lds + G_LG);
    LAS int* SELC = (LAS int*)(lds + G_SELC);
    LAS f32x2* SELW = (LAS f32x2*)(lds + G_SELW);
    LAS int* CNT = (LAS int*)(lds + G_CNT); LAS int* BASE = (LAS int*)(lds + G_BASE);
    const int tid = X.tid, lane = X.lane, w = X.wave;
#pragma unroll 1
    for (int i0 = tid; i0 < 16384; i0 += 8 * 512) { float wv[8];
#pragma unroll
        for (int k = 0; k < 8; ++k) wv[k] = X.router_w[i0 + 512 * k];
#pragma unroll
        for (int k = 0; k < 8; ++k) { const int i = i0 + 512 * k; const unsigned hi = pk2(wv[k], 0.f) & 0xffffu; const unsigned lo = pk2(wv[k] - bflo(hi), 0.f) & 0xffffu;
            RWH[(i & 15) * G_RWP + (i >> 4)] = (bf16_t)hi; RWL[(i & 15) * G_RWP + (i >> 4)] = (bf16_t)lo; } }
    { float gn[10], s0[10], s1[10];
#pragma unroll
      for (int k = 0; k < 10; ++k) { const int i = tid + 512 * k, mb = i >> 10, c = i & 1023; const float* sh = X.mod + (size_t)((l * 5 + mb) * 6 + 3) * 1024;
          gn[k] = X.norm_ffn[l * D + c]; s1[k] = sh[1024 + c]; s0[k] = sh[c]; }
      asm volatile("" : "+v"(gn[9]), "+v"(s0[9]), "+v"(s1[9]));
#pragma unroll
      for (int k = 0; k < 10; ++k) { const int i = tid + 512 * k; GM[i] = gn[k] * (s1[k] + 1.0f); SHT[i] = s0[k]; } }
    if (tid < 32) CNT[tid] = 0;
    __syncthreads();
    int row0, nrows;
    { const int NG = (l < DEPTH - 1 ? R : RL) / 16, g0 = (int)(((long)X.bid * NG) / X.G), g1 = (int)(((long)(X.bid + 1) * NG) / X.G); row0 = 16 * g0; nrows = 16 * (g1 - g0); }
    const int r16 = lane & 15, kb = lane >> 4;
    for (int gi = w; gi * 16 < nrows; gi += 8) {
        const int rl = gi * 16 + r16; const bool valid = rl < nrows; const int row = row0 + (valid ? rl : nrows - 1), mb = row_mb(row);
        const bf16_t* xr = X.xb + (size_t)row * D + 8 * kb;
        u32x4 rawa[32];
#pragma unroll
        for (int c = 0; c < 32; ++c) rawa[c] = *(const u32x4*)(xr + 32 * c);
        float ss = 0.f;
#pragma unroll
        for (int c = 0; c < 32; ++c) { f32x4 a, b; unpack8(rawa[c], a, b); ss += ((a.x * a.x + a.y * a.y) + (a.z * a.z + a.w * a.w)) + ((b.x * b.x + b.y * b.y) + (b.z * b.z + b.w * b.w)); if ((c & 3) == 3) asm volatile("" : "+v"(ss)); }
#pragma unroll
        for (int c = 0; c < 32; ++c) asm volatile("" : "+v"(rawa[c]));
        ss += shflx(ss, 16, lane); ss += shflx(ss, 32, lane);
        const float rsd = __builtin_amdgcn_rsqf(ss * (1.0f / D) + EPS);
        bf16_t* orow = X.hb + (size_t)row * D + 8 * kb;
        const LAS float* gmr = GM + mb * 1024 + 8 * kb; const LAS float* shr = SHT + mb * 1024 + 8 * kb;
        const LAS bf16_t* bhp = RWH + r16 * G_RWP + 8 * kb; const LAS bf16_t* blp = RWL + r16 * G_RWP + 8 * kb;
        f32x4 dacc = (f32x4){0.f, 0.f, 0.f, 0.f};
#pragma unroll
        for (int c0 = 0; c0 < 32; c0 += 2) {
#pragma unroll
            for (int cc = 0; cc < 2; ++cc) { const int c = c0 + cc; f32x4 a, b; unpack8(rawa[c], a, b);
                const f32x4 g0 = *(const LAS f32x4*)(gmr + 32 * c), g1 = *(const LAS f32x4*)(gmr + 32 * c + 4), h0 = *(const LAS f32x4*)(shr + 32 * c), h1 = *(const LAS f32x4*)(shr + 32 * c + 4);
                const f32x4 y0 = a * rsd * g0 + h0, y1 = b * rsd * g1 + h1;
                const u32x4 hw = pack8(y0, y1);
                if (valid) *(u32x4*)(orow + 32 * c) = hw;
                f32x4 q0, q1; unpack8(hw, q0, q1);
                const u32x4 lw = pack8(y0 - q0, y1 - q1);
                const bf16x8 bh = *(const LAS bf16x8*)(bhp + 32 * c), bl = *(const LAS bf16x8*)(blp + 32 * c);
                const bf16x8 ah = __builtin_bit_cast(bf16x8, hw), al = __builtin_bit_cast(bf16x8, lw);
                dacc = __builtin_amdgcn_mfma_f32_16x16x32_bf16(ah, bh, dacc, 0, 0, 0);
                dacc = __builtin_amdgcn_mfma_f32_16x16x32_bf16(al, bh, dacc, 0, 0, 0);
                dacc = __builtin_amdgcn_mfma_f32_16x16x32_bf16(ah, bl, dacc, 0, 0, 0); }
            asm volatile("" : "+v"(dacc) : : "memory"); }
#pragma unroll
        for (int i = 0; i < 4; ++i) { const int rr = gi * 16 + 4 * kb + i; if (rr < nrows) LG[rr * 16 + r16] = dacc[i]; }
    }
    __syncthreads();
    if (tid < nrows) {
        float aff[16], sel[16];
#pragma unroll
        for (int q = 0; q < 4; ++q) { const f32x4 t4 = *(const LAS f32x4*)(LG + tid * 16 + 4 * q); const f32x4 rb4 = *(const f32x4*)(X.router_b + 4 * q);
            aff[4 * q] = sigmoidf_(t4.x); aff[4 * q + 1] = sigmoidf_(t4.y); aff[4 * q + 2] = sigmoidf_(t4.z); aff[4 * q + 3] = sigmoidf_(t4.w);
            sel[4 * q] = aff[4 * q] + rb4.x; sel[4 * q + 1] = aff[4 * q + 1] + rb4.y; sel[4 * q + 2] = aff[4 * q + 2] + rb4.z; sel[4 * q + 3] = aff[4 * q + 3] + rb4.w; }
        int best = 0; float bs = 0.f;
#pragma unroll
        for (int g = 0; g < 4; ++g) { float m1 = sel[4 * g], m2 = -3.0e38f;
#pragma unroll
            for (int j = 1; j < 4; ++j) { const float t = sel[4 * g + j]; if (t > m1) { m2 = m1; m1 = t; } else if (t > m2) m2 = t; }
            const float gs = m1 + m2; if (g == 0 || gs > bs) { bs = gs; best = g; } }
        float s4[4], a4[4];
#pragma unroll
        for (int j = 0; j < 4; ++j) { s4[j] = best == 0 ? sel[j] : (best == 1 ? sel[4 + j] : (best == 2 ? sel[8 + j] : sel[12 + j])); a4[j] = best == 0 ? aff[j] : (best == 1 ? aff[4 + j] : (best == 2 ? aff[8 + j] : aff[12 + j])); }
        int i1 = 0; float v1 = s4[0];
#pragma unroll
        for (int j = 1; j < 4; ++j) if (s4[j] > v1) { v1 = s4[j]; i1 = j; }
        int i2 = -1; float v2 = 0.f;
#pragma unroll
        for (int j = 0; j < 4; ++j) if (j != i1 && (i2 < 0 || s4[j] > v2)) { v2 = s4[j]; i2 = j; }
        const int lo = i1 < i2 ? i1 : i2, hi = i1 < i2 ? i2 : i1;
        const float alo = lo == 0 ? a4[0] : (lo == 1 ? a4[1] : a4[2]), ahi = hi == 1 ? a4[1] : (hi == 2 ? a4[2] : a4[3]);
        const float inv = frcp(alo + ahi);
        const int pidx = lo == 0 ? hi - 1 : (lo == 1 ? hi + 1 : 5);
        const int cls = best * 6 + pidx;
        SELC[tid] = cls; SELW[tid] = (f32x2){alo * inv, ahi * inv};
        atomicAdd((int*)&CNT[cls], 1);
    }
    __syncthreads();
    if (tid < NCLS) BASE[tid] = (int)__hip_atomic_fetch_add(X.ctl + cwc + tid, (unsigned)CNT[tid], __ATOMIC_RELAXED, __HIP_MEMORY_SCOPE_AGENT);
    __syncthreads();
    if (tid < nrows) { const int c = SELC[tid]; int rank = 0; for (int j = 0; j < tid; ++j) rank += (SELC[j] == c) ? 1 : 0;
        const int pos = BASE[c] + rank; X.list[(size_t)c * CAP + pos] = row0 + tid; X.wtl[(size_t)c * CAP + pos] = SELW[tid]; }
    __syncthreads();
}

constexpr int PH_PER_LAYER = 9, N_PHASES = 1 + DEPTH * PH_PER_LAYER;
__global__ void __launch_bounds__(512, 2) k_fwd(Args a) {
    extern __shared__ __attribute__((aligned(16))) unsigned char lds_raw[];
    Base X;
    X.lds = (LAS unsigned char*)lds_raw;
    X.tid = threadIdx.x; X.lane = X.tid & 63; X.wave = __builtin_amdgcn_readfirstlane(X.tid >> 6); X.bid = blockIdx.x; X.G = gridDim.x;
    for (int u = X.tid; u < (LDS_BYTES - LDS_MISC) / 4; u += 512) ((LAS unsigned*)(X.lds + LDS_MISC))[u] = 0u;
    __syncthreads();
#if MK_MULTI
#define GRID_BAR() do { } while (0)
#else
    XcdBarrier bar = xcd_barrier_post((unsigned*)(a.ws + WS_CTL) + CW_BAR, (volatile LAS unsigned*)(X.lds + MISC_BAR));
#define GRID_BAR() do { TP_BEGIN(1, tpb_) xcd_barrier(bar); TP_END(1, tpb_, X.lds); } while (0)
#define TPW(id, ...) do { TP_BEGIN(id, tpw_) __VA_ARGS__; TP_END(id, tpw_, X.lds); } while (0)
#endif
    const int lo = a.ph_lo, hi = a.ph_hi;
#define IN(k) (lo <= (k) && (k) < hi)
#define SEAM(k) SEAMI(0, k)
#define SEAMI(idx, k) do { if (IN((k) + 1)) { TP_BEGIN(30 + (idx), tps_) GRID_BAR(); TP_END(30 + (idx), tps_, X.lds); } } while (0)
#define RUNPH(idx, k, call) do { if (PHM(idx) && IN(k)) { TPW(10 + (idx), call); if (PROBE_REP == (idx)) { GRID_BAR(); call; } SEAMI(idx, k); } } while (0)
    if (PHM(0) && IN(0)) {
        TPW(10, phase_p0(X, 0));
        if (!MK_MULTI && IN(1)) { xcd_barrier_arrive(bar); phase_p0(X, 1); xcd_barrier_wait(bar); }
        else { phase_p0(X, 1); SEAMI(0, 0); } }
    for (int l = 0; l < DEPTH; ++l) {
        const int pb = 1 + l * PH_PER_LAYER;
        if (PHM(1) && IN(pb + 0)) {
            const bool ctxw_a = !MK_MULTI && IN(pb + 1) && X.bid >= X.G - NCTX_IN;
            if (ctxw_a) xcd_barrier_arrive(bar);
            TPW(11, if (phase_norm1(X, l)) gemm_phase<K_IN, true>(X, l, 1));
            if (ctxw_a) xcd_barrier_wait(bar); else SEAMI(1, pb + 0); }
        RUNPH(2, pb + 1, (gemm_phase<K_IN, true>(X, l, 0)));
        const bool ctx_in_c = X.G == 256 && l < DEPTH - 1;
        if (PHM(3) && IN(pb + 2)) { TPW(13, if (ctx_in_c && X.bid >= X.G - 32) phase_attn(X, l, 1); phase_lru<false>(X, l); if (X.bid >= X.G - 64 && X.bid < X.G - 32) phase_carry(X, l)); if (MK_MULTI) SEAMI(3, pb + 2); }
        if (PHM(4) && IN(pb + 3)) { TPW(14, phase_attn(X, l, ctx_in_c ? 0 : 2)); if (MK_MULTI) SEAMI(4, pb + 3); }
        if (PHM(5) && IN(pb + 4)) {
            TP_BEGIN(15, tpe_)
            if (l < DEPTH - 1 && X.bid >= (int)gridDim.x - NCTX_OUT) { unsigned* ctl = (unsigned*)(a.ws + WS_CTL);
                wait_count(ctl + CW_ECTX + l * 64, 160u, ctl + CW_BAR + XB_TMO); gemm_phase<K_OUT, EPI_ALIGN_RMW>(X, l, 1); }
            else phase_lru2(X, l);
            TP_END(15, tpe_, X.lds);
            SEAMI(5, pb + 4); }
        RUNPH(6, pb + 5, (gemm_phase<K_OUT, EPI_ALIGN_RMW>(X, l, 0)));
        if (PHM(7) && IN(pb + 6)) { TPW(17, phase_router(X, l, 0)); if (PROBE_REP == 7) { GRID_BAR(); phase_router(X, l, 1); } SEAMI(7, pb + 6); }
        if (PHM(8) && IN(pb + 7)) { TPW(18, (gemm_phase<K_UP, true>(X, l, 0))); if (MK_MULTI || !IN(pb + 8)) { } }
        if (PHM(9) && IN(pb + 8)) { TPW(19, (gemm_phase<K_DOWN, EPI_ALIGN_RMW>(X, l, 0)));
            if (!MK_MULTI && l < DEPTH - 1 && IN(pb + 9)) { conv_in(X, l + 1); xcd_barrier_arrive(bar); TPW(40, phase_conv(X, l + 1)); xcd_barrier_wait(bar); }
            else { if (l < DEPTH - 1) { conv_in(X, l + 1); TPW(40, phase_conv(X, l + 1)); } SEAMI(9, pb + 8); } }
    }
#undef RUNPH
#undef IN
#undef SEAM
#if TPROF >= 0 && !MK_MULTI
    {
        __syncthreads();
        unsigned* ctl = (unsigned*)(a.ws + WS_CTL);
        const unsigned mine = *(LAS unsigned*)(X.lds + MISC_TP);
        unsigned long long target = (unsigned long long)mine * TPROF_AMP;
        if (TPROF_MEAN) {
            if (X.tid == 0) (void)__hip_atomic_fetch_add(ctl + CW_TP, mine, __ATOMIC_RELAXED, __HIP_MEMORY_SCOPE_AGENT);
            xcd_barrier(bar);
            target = 0ull;
            if (X.bid == 0) target = (unsigned long long)__hip_atomic_load(ctl + CW_TP, __ATOMIC_RELAXED, __HIP_MEMORY_SCOPE_AGENT) * TPROF_AMP / (unsigned)X.G;
        }
        if (X.tid == 0 && target > 0ull) { if (target > 1000000ull) target = 1000000ull; const unsigned t0 = tp_now(); while ((unsigned long long)(tp_now() - t0) < target) __builtin_amdgcn_s_sleep(10); }
    }
#endif
}

extern "C" void kernel_launch(void* const* d_in, const int* in_sizes, int n_in, void* d_out, int out_size, void* d_ws, size_t ws_size, hipStream_t stream) {
    static int grid = 0;
    if (grid == 0) {
        if (n_in != 25 || out_size != RL * D || ws_size < WS_END) { fprintf(stderr, "kernel_launch: unexpected shapes (n_in %d out %d ws %zu)\n", n_in, out_size, ws_size); grid = -1; return; }
        int dev = 0, cus = 0, per_cu = 0;
        if (hipGetDevice(&dev) != hipSuccess || hipDeviceGetAttribute(&cus, hipDeviceAttributeMultiprocessorCount, dev) != hipSuccess) { grid = -1; return; }
        if (hipFuncSetAttribute((const void*)k_fwd, hipFuncAttributeMaxDynamicSharedMemorySize, LDS_BYTES) != hipSuccess) { fprintf(stderr, "kernel_launch: hipFuncSetAttribute failed\n"); grid = -1; return; }
        if (hipOccupancyMaxActiveBlocksPerMultiprocessor(&per_cu, (const void*)k_fwd, 512, LDS_BYTES) != hipSuccess || per_cu < 1) fprintf(stderr, "kernel_launch: occupancy query says %d\n", per_cu);
        (void)hipGetLastError();
        grid = cus < 256 ? cus : 256;
    }
    if (grid < 0) return;
    (void)hipMemsetAsync((char*)d_ws + WS_CTL, 0, CTL_BYTES, stream);
    Args a{};
    for (int i = 0; i < 25; ++i) a.in[i] = (const float*)d_in[i];
    a.out = (float*)d_out; a.ws = (unsigned char*)d_ws;
#if MK_MULTI
    for (int p = 0; p < N_PHASES; ++p) { a.ph_lo = p; a.ph_hi = p + 1; hipLaunchKernelGGL(k_fwd, dim3(grid), dim3(512), LDS_BYTES, stream, a); }
#else
    a.ph_lo = 0; a.ph_hi = N_PHASES;
    hipLaunchKernelGGL(k_fwd, dim3(grid), dim3(512), LDS_BYTES, stream, a);
#endif
}
```
